# Optimizing an MI355X kernel written in HIP

```python
import math
import jax, jax.numpy as jnp
from jax import lax
import numpy as np

D_MODEL = 1024
BATCH = 8
SEQ = 2048
DEPTH = 4

N_META = 16
A_HEADS = 8
A_HEAD_DIM = 64
KV_LATENT = 128
IDX_HEADS = 8
IDX_DIM = 64
TOPK_MAX = 256
Q_BLOCK = 128
R_HEADS = 4
R_QK_DIM = 64
R_V_DIM = 128
R_CHUNK = 128
ROPE_BASE = 10000.0
N_EXPERTS = 64
N_GROUPS = 8
TOP_GROUPS = 4
TOP_K = 8
D_EXPERT = 256
D_SHARED = 256
ROUTE_SCALE = 2.5
MOE_BLOCK = 128
DN_ALPHA = (2 * DEPTH) ** 0.25
DN_BETA = (8 * DEPTH) ** -0.25
EPS = 1e-6

IN_COLS = (A_HEADS * A_HEAD_DIM, KV_LATENT, IDX_HEADS * IDX_DIM, IDX_DIM, IDX_HEADS,
           R_HEADS * R_QK_DIM, R_HEADS * R_QK_DIM, R_HEADS * R_V_DIM, R_HEADS * R_V_DIM)
D_IN = sum(IN_COLS)
SPLIT_POINTS = tuple(int(v) for v in np.cumsum(IN_COLS)[:-1])
V_COL_START = SPLIT_POINTS[6]
V_COL_END = SPLIT_POINTS[7]
MIX_WIDTH = A_HEADS * A_HEAD_DIM + R_HEADS * R_V_DIM

kernel_name = "hymba_dsa_retnet_deepnorm_moe"


def layer_norm(x, g, b):
    xf = x.astype(jnp.float32)
    mu = xf.mean(-1, keepdims=True)
    var = jnp.square(xf - mu).mean(-1, keepdims=True)
    return ((xf - mu) * lax.rsqrt(var + EPS) * g + b).astype(x.dtype)


def rms_norm(x, g):
    xf = x.astype(jnp.float32)
    return (xf * lax.rsqrt(jnp.square(xf).mean(-1, keepdims=True) + EPS) * g).astype(x.dtype)


def rotary(x, pos):
    half = x.shape[-1] // 2
    inv = ROPE_BASE ** (-jnp.arange(half, dtype=jnp.float32) / half)
    ang = pos.astype(jnp.float32)[:, None] * inv
    cos = jnp.cos(ang)[None, :, None, :]
    sin = jnp.sin(ang)[None, :, None, :]
    xf = x.astype(jnp.float32)
    x1, x2 = xf[..., :half], xf[..., half:]
    return jnp.concatenate([x1 * cos - x2 * sin, x1 * sin + x2 * cos], -1).astype(x.dtype)


def indexed_sparse_attention(q_lat, c_kv, q_idx, k_idx, w_idx, n_sel):
    b, t = c_kv.shape[:2]
    n_blk = -(-t // Q_BLOCK)
    pad = n_blk * Q_BLOCK - t

    def blocks(a):
        a = jnp.pad(a, [(0, 0), (0, pad)] + [(0, 0)] * (a.ndim - 2))
        return jnp.moveaxis(a.reshape(b, n_blk, Q_BLOCK, *a.shape[2:]), 1, 0)

    key_pos = jnp.arange(t)
    scale = A_HEAD_DIM ** -0.5

    def one_block(args):
        ql, qi, wi, t0 = args
        q_pos = t0 + jnp.arange(Q_BLOCK)
        causal = key_pos[None, :] <= q_pos[:, None]
        rel = jax.nn.relu(jnp.einsum('bqhd,bsd->bqhs', qi, k_idx).astype(jnp.float32))
        score = jnp.einsum('bqh,bqhs->bqs', wi.astype(jnp.float32), rel)
        score = jnp.where(causal[None], score, -jnp.inf)
        _, sel = lax.top_k(score, n_sel)
        valid = sel <= q_pos[None, :, None]
        c_sel = jax.vmap(lambda c, i: c[i])(c_kv, sel)
        logits = jnp.einsum('bqhc,bqkc->bqhk', ql, c_sel).astype(jnp.float32) * scale
        logits = jnp.where(valid[:, :, None, :], logits, -jnp.inf)
        p = jax.nn.softmax(logits, axis=-1).astype(c_sel.dtype)
        return jnp.einsum('bqhk,bqkc->bqhc', p, c_sel)

    t0s = jnp.arange(n_blk) * Q_BLOCK
    o = lax.map(one_block, (blocks(q_lat), blocks(q_idx), blocks(w_idx), t0s))
    o = jnp.moveaxis(o, 0, 1).reshape(b, n_blk * Q_BLOCK, *o.shape[3:])
    return o[:, :t]


def chunkwise_retention(q, k, v):
    b, t, h, dk = q.shape
    dv = v.shape[-1]
    n_c = -(-t // R_CHUNK)
    pad = n_c * R_CHUNK - t

    def chunks(a):
        a = jnp.pad(a.astype(jnp.float32), [(0, 0), (pad, 0), (0, 0), (0, 0)])
        return a.reshape(b, n_c, R_CHUNK, h, a.shape[-1]).transpose(1, 0, 3, 2, 4)

    log_g = jnp.log1p(-jnp.exp(jnp.linspace(math.log(1.0 / 32), math.log(1.0 / 512), R_HEADS))).astype(jnp.float32)
    idx = jnp.arange(R_CHUNK, dtype=jnp.float32)
    diff = idx[:, None] - idx[None, :]
    decay_mat = jnp.where(diff[None] >= 0, jnp.exp(diff[None] * log_g[:, None, None]), 0.0)
    q_decay = jnp.exp((idx + 1.0)[None, :] * log_g[:, None])[:, :, None]
    k_decay = jnp.exp((R_CHUNK - 1.0 - idx)[None, :] * log_g[:, None])[:, :, None]
    chunk_decay = jnp.exp(R_CHUNK * log_g)[:, None, None]

    def step(state, qkv):
        qc, kc, vc = qkv
        inner = jnp.einsum('bhnd,bhmd->bhnm', qc, kc) * decay_mat
        out = (jnp.einsum('bhnm,bhmv->bhnv', inner, vc)
               + jnp.einsum('bhnd,bhdv->bhnv', qc, state) * q_decay)
        state = chunk_decay * state + jnp.einsum('bhmd,bhmv->bhdv', kc * k_decay, vc)
        return state, out

    state0 = jnp.zeros((b, h, dk, dv), jnp.float32)
    _, o = lax.scan(step, state0, (chunks(q), chunks(k), chunks(v)))
    o = o.transpose(1, 0, 3, 2, 4).reshape(b, n_c * R_CHUNK, h, dv)
    return o[:, pad:]


def hybrid_mixer(x, w_in, w_uk, w_uv, kv_norm_w, ret_norm_w, w_o, n_sel):
    b, t, _ = x.shape
    proj = x @ w_in
    qa, ckv, qi, ki, wi, qr, kr, vr, gr = jnp.split(proj, SPLIT_POINTS, axis=-1)
    qa = qa.reshape(b, t, A_HEADS, A_HEAD_DIM)
    ckv = rms_norm(ckv, kv_norm_w)
    q_lat = jnp.einsum('bthd,hdc->bthc', qa, w_uk)
    o_lat = indexed_sparse_attention(q_lat, ckv, qi.reshape(b, t, IDX_HEADS, IDX_DIM), ki,
                                     wi * (IDX_HEADS ** -0.5), n_sel)
    out_a = jnp.einsum('bthc,hcd->bthd', o_lat, w_uv).reshape(b, t, A_HEADS * A_HEAD_DIM)
    pos = jnp.arange(t)
    qr = rotary(qr.reshape(b, t, R_HEADS, R_QK_DIM), pos)
    kr = rotary(kr.reshape(b, t, R_HEADS, R_QK_DIM), pos) * (R_QK_DIM ** -0.5)
    o_r = chunkwise_retention(qr, kr, vr.reshape(b, t, R_HEADS, R_V_DIM))
    mu = o_r.mean(-1, keepdims=True)
    var = jnp.square(o_r - mu).mean(-1, keepdims=True)
    o_r = ((o_r - mu) * lax.rsqrt(var + EPS)).reshape(b, t, R_HEADS * R_V_DIM) * ret_norm_w
    out_b = jax.nn.silu(gr) * o_r.astype(x.dtype)
    return jnp.concatenate([out_a, out_b], axis=-1) @ w_o


def routed_experts(xf, top_idx, top_w, w_gate, w_up, w_down):
    n_tok, d = xf.shape
    n_assign = n_tok * TOP_K
    n_blocks = -(-n_assign // MOE_BLOCK) + N_EXPERTS
    n_rows = n_blocks * MOE_BLOCK
    expert_flat = top_idx.reshape(-1)
    token_flat = jnp.arange(n_assign, dtype=jnp.int32) // TOP_K
    gate_flat = top_w.reshape(-1)
    order = jnp.argsort(expert_flat)
    e_sorted = expert_flat[order]
    counts = jnp.bincount(expert_flat, length=N_EXPERTS)
    blocks_per_e = (counts + MOE_BLOCK - 1) // MOE_BLOCK
    blk_end = jnp.cumsum(blocks_per_e)
    blk_start = blk_end - blocks_per_e
    seg_start = jnp.cumsum(counts) - counts
    row = blk_start[e_sorted] * MOE_BLOCK + (jnp.arange(n_assign) - seg_start[e_sorted])
    row_token = jnp.zeros((n_rows,), jnp.int32).at[row].set(token_flat[order])
    row_gate = jnp.zeros((n_rows,), xf.dtype).at[row].set(gate_flat[order].astype(xf.dtype))
    block_expert = jnp.minimum(jnp.searchsorted(blk_end, jnp.arange(n_blocks), side='right'),
                               N_EXPERTS - 1)
    x_rows = xf[row_token].reshape(n_blocks, MOE_BLOCK, d)

    def block_ffn(args):
        xb, e = args
        hdn = jax.nn.silu(xb @ w_gate[e]) * (xb @ w_up[e])
        return hdn @ w_down[e]

    y_rows = lax.map(block_ffn, (x_rows, block_expert)).reshape(n_rows, d)
    return jax.ops.segment_sum(y_rows * row_gate[:, None], row_token, num_segments=n_tok)


def moe_ffn(x, w_router, router_bias, w_gate, w_up, w_down, ws_gate, ws_up, ws_down):
    b, t, d = x.shape
    xf = x.reshape(-1, d)
    scores = jax.nn.sigmoid((xf @ w_router).astype(jnp.float32))
    sel_scores = scores + router_bias.astype(jnp.float32)
    grp = sel_scores.reshape(-1, N_GROUPS, N_EXPERTS // N_GROUPS)
    grp_score = lax.top_k(grp, 2)[0].sum(-1)
    _, top_grp = lax.top_k(grp_score, TOP_GROUPS)
    grp_mask = jnp.any(top_grp[..., None] == jnp.arange(N_GROUPS), axis=-2)
    expert_mask = jnp.repeat(grp_mask, N_EXPERTS // N_GROUPS, axis=-1)
    _, top_idx = lax.top_k(jnp.where(expert_mask, sel_scores, -jnp.inf), TOP_K)
    gates = jnp.take_along_axis(scores, top_idx, axis=-1)
    gates = gates / gates.sum(-1, keepdims=True) * ROUTE_SCALE
    routed = routed_experts(xf, top_idx, gates, w_gate, w_up, w_down)
    shared = (jax.nn.silu(xf @ ws_gate) * (xf @ ws_up)) @ ws_down
    return (routed + shared).reshape(b, t, d)


def setup_inputs(seed: int = 0) -> dict:
    key = jax.random.key(seed)
    ks = jax.random.split(key, 24)
    L = DEPTH

    def nrm(k, shape, scale):
        return jax.random.normal(k, shape, jnp.float32) * scale

    x = nrm(ks[0], (BATCH, SEQ, D_MODEL), 1.0)
    meta_tokens = nrm(ks[1], (N_META, D_MODEL), 1.0)
    w_in = nrm(ks[2], (L, D_MODEL, D_IN), D_MODEL ** -0.5)
    w_in = w_in.at[:, :, V_COL_START:V_COL_END].multiply(DN_BETA)
    w_uk = nrm(ks[3], (L, A_HEADS, A_HEAD_DIM, KV_LATENT), KV_LATENT ** -0.5)
    w_uv = nrm(ks[4], (L, A_HEADS, KV_LATENT, A_HEAD_DIM), KV_LATENT ** -0.5 * DN_BETA)
    kv_norm_w = 1.0 + nrm(ks[5], (L, KV_LATENT), 0.02)
    ret_norm_w = 1.0 + nrm(ks[6], (L, R_HEADS * R_V_DIM), 0.02)
    w_o = nrm(ks[7], (L, MIX_WIDTH, D_MODEL), MIX_WIDTH ** -0.5 * DN_BETA)
    ln1_g = 1.0 + nrm(ks[8], (L, D_MODEL), 0.02)
    ln1_b = nrm(ks[9], (L, D_MODEL), 0.02)
    w_router = nrm(ks[10], (L, D_MODEL, N_EXPERTS), D_MODEL ** -0.5)
    router_bias = nrm(ks[11], (L, N_EXPERTS), 0.01)
    w_gate = nrm(ks[12], (L, N_EXPERTS, D_MODEL, D_EXPERT), D_MODEL ** -0.5)
    w_up = nrm(ks[13], (L, N_EXPERTS, D_MODEL, D_EXPERT), D_MODEL ** -0.5)
    w_down = nrm(ks[14], (L, N_EXPERTS, D_EXPERT, D_MODEL), D_EXPERT ** -0.5 * DN_BETA)
    ws_gate = nrm(ks[15], (L, D_MODEL, D_SHARED), D_MODEL ** -0.5)
    ws_up = nrm(ks[16], (L, D_MODEL, D_SHARED), D_MODEL ** -0.5)
    ws_down = nrm(ks[17], (L, D_SHARED, D_MODEL), D_SHARED ** -0.5 * DN_BETA)
    ln2_g = 1.0 + nrm(ks[18], (L, D_MODEL), 0.02)
    ln2_b = nrm(ks[19], (L, D_MODEL), 0.02)
    return {"x": x, "meta_tokens": meta_tokens, "w_in": w_in, "w_uk": w_uk, "w_uv": w_uv,
            "kv_norm_w": kv_norm_w, "ret_norm_w": ret_norm_w, "w_o": w_o,
            "ln1_g": ln1_g, "ln1_b": ln1_b, "w_router": w_router, "router_bias": router_bias,
            "w_gate": w_gate, "w_up": w_up, "w_down": w_down,
            "ws_gate": ws_gate, "ws_up": ws_up, "ws_down": ws_down,
            "ln2_g": ln2_g, "ln2_b": ln2_b}


def reference(x, meta_tokens, w_in, w_uk, w_uv, kv_norm_w, ret_norm_w, w_o, ln1_g, ln1_b,
              w_router, router_bias, w_gate, w_up, w_down, ws_gate, ws_up, ws_down,
              ln2_g, ln2_b):
    b, s, d = x.shape
    n_sel = min(TOPK_MAX, s // 4)
    meta = jnp.broadcast_to(meta_tokens.astype(x.dtype)[None], (b, N_META, d))
    h = jnp.concatenate([meta, x], axis=1)
    for l in range(DEPTH):
        mix = hybrid_mixer(h, w_in[l], w_uk[l], w_uv[l], kv_norm_w[l], ret_norm_w[l], w_o[l], n_sel)
        h = layer_norm(DN_ALPHA * h + mix, ln1_g[l], ln1_b[l])
        ffn = moe_ffn(h, w_router[l], router_bias[l], w_gate[l], w_up[l], w_down[l],
                      ws_gate[l], ws_up[l], ws_down[l])
        h = layer_norm(DN_ALPHA * h + ffn, ln2_g[l], ln2_b[l])
    return h[:, N_META:]
```

```cpp
#include <hip/hip_runtime.h>
#include <stdint.h>
#include <stdio.h>
#include <string.h>

typedef unsigned short bf16_t;
typedef short bf16x8 __attribute__((ext_vector_type(8)));
typedef float f32x16 __attribute__((ext_vector_type(16)));
typedef float f32x4 __attribute__((ext_vector_type(4)));

constexpr int D = 1024, BATCH = 8, SEQ = 2048, NMETA = 16, T = SEQ + NMETA, M = BATCH * T, NL = 4;
constexpr int DIN = 2760, DINP = 2816;
constexpr int NE = 64, TOPK = 8, DE = 256;
constexpr int NSEL = 256;
constexpr int C_QA = 0, C_CKV = 512, C_QI = 640, C_KI = 1152, C_WI = 1216, C_QR = 1224, C_KR = 1480, C_VR = 1736, C_GR = 2248;
constexpr float DN_ALPHA = 1.681792830507429f;
constexpr float EPS = 1e-6f;
constexpr int MAXTILES = 1232;
constexpr int RMAX = MAXTILES * 128;

__device__ __forceinline__ bf16_t f2bf(float f) { unsigned u = __float_as_uint(f); return (bf16_t)((u + 0x7fffu + ((u >> 16) & 1u)) >> 16); }
__device__ __forceinline__ float bf2f(bf16_t h) { return __uint_as_float(((unsigned)h) << 16); }

__global__ void k_build_h0(const float* __restrict__ x, const float* __restrict__ meta, float* __restrict__ hf, bf16_t* __restrict__ hb) {
    size_t i = (size_t)blockIdx.x * blockDim.x + threadIdx.x;
    if (i >= (size_t)M * D / 4) return;
    size_t e = i * 4; int row = (int)(e / D), col = (int)(e % D);
    int b = row / T, t = row % T;
    const float* src = (t < NMETA) ? (meta + (size_t)t * D + col) : (x + ((size_t)b * SEQ + (t - NMETA)) * D + col);
    f32x4 v = *(const f32x4*)src;
    *(f32x4*)(hf + e) = v;
    ushort4 o; o.x = f2bf(v[0]); o.y = f2bf(v[1]); o.z = f2bf(v[2]); o.w = f2bf(v[3]);
    *(ushort4*)(hb + e) = o;
}

__global__ void k_transpose(const float* __restrict__ W, bf16_t* __restrict__ Wt, int K, int N, size_t w_zstride, size_t wt_zstride, int ldwt, int G, int gstride, int row_off) {
    __shared__ float tile[32][33];
    const float* Wz = W + (size_t)blockIdx.z * w_zstride; bf16_t* Wtz = Wt + (size_t)blockIdx.z * wt_zstride;
    int n0 = blockIdx.x * 32, k0 = blockIdx.y * 32, tx = threadIdx.x, ty = threadIdx.y;
    for (int i = 0; i < 4; ++i) { int k = k0 + ty + 8 * i, n = n0 + tx; tile[ty + 8 * i][tx] = (k < K && n < N) ? Wz[(size_t)k * N + n] : 0.f; }
    __syncthreads();
    for (int i = 0; i < 4; ++i) { int n = n0 + ty + 8 * i, k = k0 + tx; if (n < N && k < K) { int dn = (n / G) * gstride + (n % G) + row_off; Wtz[(size_t)dn * ldwt + k] = f2bf(tile[tx][ty + 8 * i]); } }
}
__global__ void k_zero_bf16(bf16_t* p, size_t n) { size_t i = (size_t)blockIdx.x * blockDim.x + threadIdx.x; if (i < n) p[i] = 0; }

struct GemmP {
    const bf16_t* A; const int* rowmap; const bf16_t* Bt; const int* tile_expert; const int* ntiles;
    size_t bt_zstride, bt_estride;
    int lda, a_zoff, ldb, Mr, N, K;
};
static GemmP mk_gemm(const bf16_t* A, int lda, int a_zoff, const int* rowmap, const bf16_t* Bt, int ldb, size_t bt_zstride, int Mr, int N, int K, const int* tile_expert, const int* ntiles, size_t bt_estride) {
    GemmP p; memset(&p, 0, sizeof(p)); p.A = A; p.rowmap = rowmap; p.Bt = Bt; p.tile_expert = tile_expert; p.ntiles = ntiles; p.bt_zstride = bt_zstride; p.bt_estride = bt_estride;
    p.lda = lda; p.a_zoff = a_zoff; p.ldb = ldb; p.Mr = Mr; p.N = N; p.K = K; return p;
}
struct EpiF32 { float* C; int ldc; int pad; __device__ void operator()(int r, int c, int z, float v) const { C[(size_t)r * ldc + c] = v; } };
struct EpiBf16 { bf16_t* C; int ldc; int c_zoff; float scale; int pad; __device__ void operator()(int r, int c, int z, float v) const { C[(size_t)r * ldc + c + z * c_zoff] = f2bf(v * scale); } };
struct EpiResid { const float* h; float* y; float alpha; int pad; __device__ void operator()(int r, int c, int z, float v) const { size_t i = (size_t)r * D + c; y[i] = alpha * h[i] + v; } };
struct EpiSwiglu { bf16_t* hdn; __device__ void pair(int r, int j, float g, float u) const { float s = g / (1.f + __expf(-g)); hdn[(size_t)r * DE + j] = f2bf(s * u); } };

template <class Epi, bool PAIR>
__global__ void __launch_bounds__(256) k_gemm(GemmP p, Epi epi) {
    const int tid = threadIdx.x, lane = tid & 63, w = tid >> 6, wm = w >> 1, wn = w & 1, z = blockIdx.z;
    const int bm = blockIdx.x, bn = blockIdx.y;
    const bf16_t* Bt = p.Bt + (size_t)z * p.bt_zstride;
    if (p.tile_expert) { if (bm >= *p.ntiles) return; Bt += (size_t)p.tile_expert[bm] * p.bt_estride; }
    const int r32 = lane & 31, hi = lane >> 5;
    const bf16_t* ap[2]; const bf16_t* bp[2];
#pragma unroll
    for (int i = 0; i < 2; ++i) {
        int r = bm * 128 + wm * 64 + i * 32 + r32; if (r > p.Mr - 1) r = p.Mr - 1;
        int ar = p.rowmap ? p.rowmap[r] : r;
        ap[i] = p.A + (size_t)ar * p.lda + z * p.a_zoff + hi * 8;
        int c = bn * 128 + wn * 64 + i * 32 + r32; if (c > p.N - 1) c = p.N - 1;
        bp[i] = Bt + (size_t)c * p.ldb + hi * 8;
    }
    f32x16 acc[2][2];
#pragma unroll
    for (int i = 0; i < 2; ++i)
#pragma unroll
        for (int j = 0; j < 2; ++j)
#pragma unroll
            for (int q = 0; q < 16; ++q) acc[i][j][q] = 0.f;
    for (int k = 0; k < p.K; k += 16) {
        bf16x8 a0 = *(const bf16x8*)(ap[0] + k), a1 = *(const bf16x8*)(ap[1] + k);
        bf16x8 b0 = *(const bf16x8*)(bp[0] + k), b1 = *(const bf16x8*)(bp[1] + k);
        acc[0][0] = __builtin_amdgcn_mfma_f32_32x32x16_bf16(a0, b0, acc[0][0], 0, 0, 0);
        acc[0][1] = __builtin_amdgcn_mfma_f32_32x32x16_bf16(a0, b1, acc[0][1], 0, 0, 0);
        acc[1][0] = __builtin_amdgcn_mfma_f32_32x32x16_bf16(a1, b0, acc[1][0], 0, 0, 0);
        acc[1][1] = __builtin_amdgcn_mfma_f32_32x32x16_bf16(a1, b1, acc[1][1], 0, 0, 0);
    }
#pragma unroll
    for (int i = 0; i < 2; ++i)
#pragma unroll
        for (int q = 0; q < 16; ++q) {
            int r = bm * 128 + wm * 64 + i * 32 + (q & 3) + 8 * (q >> 2) + 4 * hi;
            if (r >= p.Mr) continue;
            if constexpr (PAIR) {
                int j = (bn * 2 + wn) * 32 + r32;
                epi.pair(r, j, acc[i][0][q], acc[i][1][q]);
            } else {
#pragma unroll
                for (int jn = 0; jn < 2; ++jn) { int c = bn * 128 + wn * 64 + jn * 32 + r32; if (c < p.N) epi(r, c, z, acc[i][jn][q]); }
            }
        }
}

__global__ void __launch_bounds__(256) k_post_proj(const float* __restrict__ proj, const float* __restrict__ kvw, bf16_t* qa, bf16_t* ckv, bf16_t* qi, bf16_t* ki, float* wi,
                                                   float* qr, float* kr, float* vr, float* gr) {
    const int row = blockIdx.x, tid = threadIdx.x, t = row % T;
    const float* p = proj + (size_t)row * DINP;
    __shared__ float red[4];
    for (int c = tid; c < 512; c += 256) { qa[(size_t)row * 512 + c] = f2bf(p[C_QA + c]); qi[(size_t)row * 512 + c] = f2bf(p[C_QI + c]); vr[(size_t)row * 512 + c] = p[C_VR + c]; gr[(size_t)row * 512 + c] = p[C_GR + c]; }
    if (tid < 64) ki[(size_t)row * 64 + tid] = f2bf(p[C_KI + tid]);
    if (tid < 8) wi[(size_t)row * 8 + tid] = p[C_WI + tid] * 0.35355339059327373f;
    float v = (tid < 128) ? p[C_CKV + tid] : 0.f; float s = v * v;
    for (int o = 32; o > 0; o >>= 1) s += __shfl_xor(s, o);
    if ((tid & 63) == 0) red[tid >> 6] = s;
    __syncthreads();
    float tot = red[0] + red[1] + red[2] + red[3];
    float rs = rsqrtf(tot * (1.f / 128.f) + EPS);
    if (tid < 128) ckv[(size_t)row * 128 + tid] = f2bf(v * rs * kvw[tid]);
    if (tid < 128) {
        int hh = tid >> 5, i = tid & 31;
        float inv = exp2f(-(float)i * (13.287712379549449f / 32.f));
        float ang = (float)t * inv; float sn, cs; sincosf(ang, &sn, &cs);
        float x1 = p[C_QR + hh * 64 + i], x2 = p[C_QR + hh * 64 + 32 + i];
        qr[(size_t)row * 256 + hh * 64 + i] = x1 * cs - x2 * sn; qr[(size_t)row * 256 + hh * 64 + 32 + i] = x1 * sn + x2 * cs;
        x1 = p[C_KR + hh * 64 + i]; x2 = p[C_KR + hh * 64 + 32 + i];
        kr[(size_t)row * 256 + hh * 64 + i] = (x1 * cs - x2 * sn) * 0.125f; kr[(size_t)row * 256 + hh * 64 + 32 + i] = (x1 * sn + x2 * cs) * 0.125f;
    }
}

__device__ __forceinline__ unsigned fkey(float f) { unsigned u = __float_as_uint(f); return (u & 0x80000000u) ? ~u : (u | 0x80000000u); }
__global__ void __launch_bounds__(256) k_attn_naive(const bf16_t* __restrict__ qi, const bf16_t* __restrict__ ki, const float* __restrict__ wi, const bf16_t* __restrict__ qlat,
                                                    const bf16_t* __restrict__ ckv, bf16_t* __restrict__ olat) {
    const int row = blockIdx.x, tid = threadIdx.x, b = row / T, t = row % T, n = t + 1;
    __shared__ float s_q[512]; __shared__ float s_w[8]; __shared__ unsigned s_key[T]; __shared__ int s_sel[NSEL]; __shared__ float s_ql[1024]; __shared__ float s_p[8 * NSEL];
    __shared__ int s_cnt; __shared__ int s_cg[256]; __shared__ int s_ce[256]; __shared__ float s_red[8][4]; __shared__ float s_m[8], s_l[8];
    for (int c = tid; c < 512; c += 256) s_q[c] = bf2f(qi[(size_t)row * 512 + c]);
    for (int c = tid; c < 1024; c += 256) s_ql[c] = bf2f(qlat[(size_t)row * 1024 + c]);
    if (tid < 8) s_w[tid] = wi[(size_t)row * 8 + tid];
    __syncthreads();
    const size_t kb = (size_t)b * T;
    for (int s = tid; s < n; s += 256) {
        const bf16_t* kr = ki + (kb + s) * 64; float kv[64];
#pragma unroll
        for (int d = 0; d < 64; ++d) kv[d] = bf2f(kr[d]);
        float sc = 0.f;
#pragma unroll
        for (int h = 0; h < 8; ++h) { float a = 0.f;
#pragma unroll
            for (int d = 0; d < 64; ++d) a += s_q[h * 64 + d] * kv[d];
            sc += s_w[h] * fmaxf(a, 0.f); }
        s_key[s] = fkey(sc);
    }
    if (tid == 0) s_cnt = 0;
    __syncthreads();
    int nsel;
    if (n <= NSEL) { for (int s = tid; s < n; s += 256) s_sel[s] = s; nsel = n; }
    else {
        unsigned prefix = 0;
        for (int bit = 31; bit >= 0; --bit) {
            unsigned cand = prefix | (1u << bit); int c = 0;
            for (int s = tid; s < n; s += 256) c += (s_key[s] >= cand) ? 1 : 0;
            for (int o = 32; o > 0; o >>= 1) c += __shfl_xor(c, o);
            if ((tid & 63) == 0) atomicAdd(&s_cnt, c);
            __syncthreads();
            int tot = s_cnt;
            __syncthreads();
            if (tid == 0) s_cnt = 0;
            if (tot >= NSEL) prefix = cand;
            __syncthreads();
        }
        int c = 0;
        for (int s = tid; s < n; s += 256) c += (s_key[s] > prefix) ? 1 : 0;
        for (int o = 32; o > 0; o >>= 1) c += __shfl_xor(c, o);
        if ((tid & 63) == 0) atomicAdd(&s_cnt, c);
        __syncthreads();
        const int cgt = s_cnt, need_eq = NSEL - cgt;
        __syncthreads();
        if (tid == 0) s_cnt = 0;
        __syncthreads();
        { int cg = 0, ce = 0;
          for (int i = 0; i < 9; ++i) { int s = tid * 9 + i; if (s < n) { unsigned u = s_key[s]; cg += (u > prefix) ? 1 : 0; ce += (u == prefix) ? 1 : 0; } }
          s_cg[tid] = cg; s_ce[tid] = ce;
          __syncthreads();
          int pg = 0, pe = 0; for (int j = 0; j < tid; ++j) { pg += s_cg[j]; pe += s_ce[j]; }
          for (int i = 0; i < 9; ++i) { int s = tid * 9 + i; if (s < n) { unsigned u = s_key[s];
              if (u > prefix) { int pos = pg + (pe < need_eq ? pe : need_eq); s_sel[pos] = s; ++pg; }
              else if (u == prefix) { if (pe < need_eq) s_sel[pg + pe] = s; ++pe; } } }
        }
        nsel = NSEL;
    }
    __syncthreads();
    float lg[8];
    if (tid < nsel) {
        const bf16_t* cr = ckv + (kb + s_sel[tid]) * 128;
#pragma unroll
        for (int h = 0; h < 8; ++h) lg[h] = 0.f;
        for (int c = 0; c < 128; ++c) { float cv = bf2f(cr[c]);
#pragma unroll
            for (int h = 0; h < 8; ++h) lg[h] += s_ql[h * 128 + c] * cv; }
    } else {
#pragma unroll
        for (int h = 0; h < 8; ++h) lg[h] = -INFINITY;
    }
#pragma unroll
    for (int h = 0; h < 8; ++h) { float m = lg[h]; for (int o = 32; o > 0; o >>= 1) m = fmaxf(m, __shfl_xor(m, o)); if ((tid & 63) == 0) s_red[h][tid >> 6] = m; }
    __syncthreads();
    if (tid < 8) s_m[tid] = fmaxf(fmaxf(s_red[tid][0], s_red[tid][1]), fmaxf(s_red[tid][2], s_red[tid][3]));
    __syncthreads();
    float pe[8];
#pragma unroll
    for (int h = 0; h < 8; ++h) { pe[h] = (tid < nsel) ? __expf(lg[h] - s_m[h]) : 0.f; s_p[h * NSEL + tid] = pe[h]; }
    __syncthreads();
#pragma unroll
    for (int h = 0; h < 8; ++h) { float l = pe[h]; for (int o = 32; o > 0; o >>= 1) l += __shfl_xor(l, o); if ((tid & 63) == 0) s_red[h][tid >> 6] = l; }
    __syncthreads();
    if (tid < 8) s_l[tid] = s_red[tid][0] + s_red[tid][1] + s_red[tid][2] + s_red[tid][3];
    __syncthreads();
    { const int h = tid >> 5, c0 = (tid & 31) * 4; float o0 = 0, o1 = 0, o2 = 0, o3 = 0;
      for (int k = 0; k < nsel; ++k) { const bf16_t* cr = ckv + (kb + s_sel[k]) * 128 + c0; float pv = s_p[h * NSEL + k]; ushort4 cv = *(const ushort4*)cr;
          o0 += pv * bf2f(cv.x); o1 += pv * bf2f(cv.y); o2 += pv * bf2f(cv.z); o3 += pv * bf2f(cv.w); }
      float il = 1.f / s_l[h]; ushort4 ov; ov.x = f2bf(o0 * il); ov.y = f2bf(o1 * il); ov.z = f2bf(o2 * il); ov.w = f2bf(o3 * il);
      *(ushort4*)(olat + (size_t)row * 1024 + h * 128 + c0) = ov; }
}

__global__ void __launch_bounds__(256) k_ret_naive(const float* __restrict__ qr, const float* __restrict__ kr, const float* __restrict__ vr, float* __restrict__ oret) {
    const int b = blockIdx.x >> 2, hh = blockIdx.x & 3, tid = threadIdx.x, v = tid & 127, dh = tid >> 7;
    const float xh = -3.4657359027997265f + (float)hh * (-0.9241962407465937f);
    const float gamma = 1.f - expf(xh);
    float S[32];
#pragma unroll
    for (int i = 0; i < 32; ++i) S[i] = 0.f;
    __shared__ float sq[64], sk[64], part[2][128];
    for (int t = 0; t < T; ++t) {
        const size_t row = (size_t)b * T + t;
        if (tid < 64) sq[tid] = qr[row * 256 + hh * 64 + tid]; else if (tid < 128) sk[tid - 64] = kr[row * 256 + hh * 64 + tid - 64];
        const float vv = vr[row * 512 + hh * 128 + v];
        __syncthreads();
        float o = 0.f;
#pragma unroll
        for (int i = 0; i < 32; ++i) { S[i] = gamma * S[i] + sk[dh * 32 + i] * vv; o += sq[dh * 32 + i] * S[i]; }
        part[dh][v] = o;
        __syncthreads();
        if (dh == 0) oret[row * 512 + hh * 128 + v] = part[0][v] + part[1][v];
    }
}
__global__ void __launch_bounds__(128) k_ret_post(const float* __restrict__ oret, const float* __restrict__ gr, const float* __restrict__ rw, bf16_t* __restrict__ mix) {
    const int row = blockIdx.x >> 2, hh = blockIdx.x & 3, v = threadIdx.x;
    __shared__ float red[2];
    const float x = oret[(size_t)row * 512 + hh * 128 + v];
    float s = x; for (int o = 32; o > 0; o >>= 1) s += __shfl_xor(s, o);
    if ((v & 63) == 0) red[v >> 6] = s;
    __syncthreads();
    const float mu = (red[0] + red[1]) * (1.f / 128.f);
    __syncthreads();
    const float dx = x - mu; float q = dx * dx; for (int o = 32; o > 0; o >>= 1) q += __shfl_xor(q, o);
    if ((v & 63) == 0) red[v >> 6] = q;
    __syncthreads();
    const float rstd = rsqrtf((red[0] + red[1]) * (1.f / 128.f) + EPS);
    const float on = dx * rstd * rw[hh * 128 + v];
    const float g = gr[(size_t)row * 512 + hh * 128 + v];
    mix[(size_t)row * 1024 + 512 + hh * 128 + v] = f2bf(g / (1.f + __expf(-g)) * on);
}

__device__ __forceinline__ float block_sum256(float v, float* red) {
    for (int o = 32; o > 0; o >>= 1) v += __shfl_xor(v, o);
    __syncthreads();
    if ((threadIdx.x & 63) == 0) red[threadIdx.x >> 6] = v;
    __syncthreads();
    return red[0] + red[1] + red[2] + red[3];
}
__global__ void __launch_bounds__(256) k_ln1_route(const float* __restrict__ y1, const float* __restrict__ g, const float* __restrict__ bta, const float* __restrict__ wr, const float* __restrict__ rbias,
                                                   float* __restrict__ hf1, bf16_t* __restrict__ hb1, int* __restrict__ cnt, int* __restrict__ list_tok, int* __restrict__ tok_e, int* __restrict__ tok_pos, float* __restrict__ tok_gate) {
    const int row = blockIdx.x, tid = threadIdx.x;
    __shared__ float red[4]; __shared__ float s_h[D]; __shared__ float s_part[4][64]; __shared__ float s_score[64]; __shared__ float s_selv[64]; __shared__ float s_gs[8]; __shared__ int s_idx[8];
    f32x4 v = *(const f32x4*)(y1 + (size_t)row * D + tid * 4);
    const float mu = block_sum256((v[0] + v[1]) + (v[2] + v[3]), red) * (1.f / D);
    f32x4 d = v - mu;
    const float var = block_sum256((d[0] * d[0] + d[1] * d[1]) + (d[2] * d[2] + d[3] * d[3]), red) * (1.f / D);
    const float rstd = rsqrtf(var + EPS);
    f32x4 gg = *(const f32x4*)(g + tid * 4), bb = *(const f32x4*)(bta + tid * 4);
    f32x4 h = d * rstd * gg + bb;
    *(f32x4*)(hf1 + (size_t)row * D + tid * 4) = h;
    ushort4 o; o.x = f2bf(h[0]); o.y = f2bf(h[1]); o.z = f2bf(h[2]); o.w = f2bf(h[3]);
    *(ushort4*)(hb1 + (size_t)row * D + tid * 4) = o;
    s_h[tid * 4 + 0] = h[0]; s_h[tid * 4 + 1] = h[1]; s_h[tid * 4 + 2] = h[2]; s_h[tid * 4 + 3] = h[3];
    __syncthreads();
    { const int e = tid & 63, pq = tid >> 6; float a = 0.f;
      for (int dd = pq * 256; dd < pq * 256 + 256; ++dd) a += s_h[dd] * wr[(size_t)dd * NE + e];
      s_part[pq][e] = a; }
    __syncthreads();
    if (tid < 64) { float lg = (s_part[0][tid] + s_part[1][tid]) + (s_part[2][tid] + s_part[3][tid]); s_score[tid] = 1.f / (1.f + expf(-lg)); }
    __syncthreads();
    if (tid < 64) s_selv[tid] = s_score[tid] + rbias[tid];
    __syncthreads();
    if (tid < 8) { float m1 = -INFINITY, m2 = -INFINITY; for (int j = 0; j < 8; ++j) { float x = s_selv[tid * 8 + j]; if (x > m1) { m2 = m1; m1 = x; } else if (x > m2) m2 = x; } s_gs[tid] = m1 + m2; }
    __syncthreads();
    if (tid == 0) {
        unsigned gmask = 0;
        for (int k = 0; k < 4; ++k) { int best = -1; float bv = -INFINITY; for (int gi = 0; gi < 8; ++gi) if (!((gmask >> gi) & 1u) && (best < 0 || s_gs[gi] > bv)) { best = gi; bv = s_gs[gi]; } gmask |= 1u << best; }
        unsigned long long taken = 0; float ssum = 0.f;
        for (int k = 0; k < 8; ++k) { int best = -1; float bv = -INFINITY;
            for (int e = 0; e < 64; ++e) if (((gmask >> (e >> 3)) & 1u) && !((taken >> e) & 1ull) && (best < 0 || s_selv[e] > bv)) { best = e; bv = s_selv[e]; }
            taken |= 1ull << best; s_idx[k] = best; ssum += s_score[best]; }
        for (int k = 0; k < 8; ++k) { const int e = s_idx[k]; const int pos = atomicAdd(&cnt[e], 1); list_tok[(size_t)e * M + pos] = row;
            tok_e[row * 8 + k] = e; tok_pos[row * 8 + k] = pos; tok_gate[row * 8 + k] = s_score[e] / ssum * 2.5f; }
    }
}
__global__ void k_moe_offsets(const int* __restrict__ cnt, int* __restrict__ off, int* __restrict__ tile_expert, int* __restrict__ ntiles) {
    if (threadIdx.x != 0 || blockIdx.x != 0) return;
    int acc = 0, ti = 0;
    for (int e = 0; e < NE; ++e) { off[e] = acc; int nt = (cnt[e] + 127) / 128; for (int i = 0; i < nt; ++i) tile_expert[ti++] = e; acc += nt * 128; }
    off[NE] = acc; for (int i = 0; i < M / 128; ++i) tile_expert[ti++] = NE; acc += M; off[NE + 1] = acc; *ntiles = ti;
}
__global__ void k_moe_scatter(const int* __restrict__ cnt, const int* __restrict__ off, const int* __restrict__ list_tok, int* __restrict__ row_token) {
    const int e = blockIdx.x, pos = blockIdx.y * 256 + threadIdx.x;
    if (e == NE) { if (pos < M) row_token[off[NE] + pos] = pos; return; }
    const int c = cnt[e], padded = (c + 127) / 128 * 128;
    if (pos < c) row_token[off[e] + pos] = list_tok[(size_t)e * M + pos]; else if (pos < padded) row_token[off[e] + pos] = 0;
}
__global__ void __launch_bounds__(256) k_combine_ln2(const float* __restrict__ hf1, const bf16_t* __restrict__ yrows, const int* __restrict__ off, const int* __restrict__ tok_e, const int* __restrict__ tok_pos,
                                                     const float* __restrict__ tok_gate, const float* __restrict__ g, const float* __restrict__ bta, float* __restrict__ hf, bf16_t* __restrict__ hb, float* __restrict__ out) {
    const int row = blockIdx.x, tid = threadIdx.x;
    __shared__ float red[4];
    f32x4 h1 = *(const f32x4*)(hf1 + (size_t)row * D + tid * 4);
    f32x4 y = h1 * DN_ALPHA;
    for (int k = 0; k < 9; ++k) {
        size_t r; float gt;
        if (k < 8) { r = (size_t)off[tok_e[row * 8 + k]] + tok_pos[row * 8 + k]; gt = tok_gate[row * 8 + k]; } else { r = (size_t)off[NE] + row; gt = 1.f; }
        ushort4 yv = *(const ushort4*)(yrows + r * D + tid * 4);
        y[0] += gt * bf2f(yv.x); y[1] += gt * bf2f(yv.y); y[2] += gt * bf2f(yv.z); y[3] += gt * bf2f(yv.w);
    }
    const float mu = block_sum256((y[0] + y[1]) + (y[2] + y[3]), red) * (1.f / D);
    f32x4 d = y - mu;
    const float var = block_sum256((d[0] * d[0] + d[1] * d[1]) + (d[2] * d[2] + d[3] * d[3]), red) * (1.f / D);
    const float rstd = rsqrtf(var + EPS);
    f32x4 gg = *(const f32x4*)(g + tid * 4), bb = *(const f32x4*)(bta + tid * 4);
    f32x4 h = d * rstd * gg + bb;
    *(f32x4*)(hf + (size_t)row * D + tid * 4) = h;
    ushort4 o; o.x = f2bf(h[0]); o.y = f2bf(h[1]); o.z = f2bf(h[2]); o.w = f2bf(h[3]);
    *(ushort4*)(hb + (size_t)row * D + tid * 4) = o;
    if (out) { const int b = row / T, t = row % T; if (t >= NMETA) *(f32x4*)(out + ((size_t)b * SEQ + (t - NMETA)) * D + tid * 4) = h; }
}

static inline size_t al(size_t x) { return (x + 255) & ~(size_t)255; }
extern "C" void kernel_launch(void* const* d_in, const int* in_sizes, int n_in, void* d_out, int out_size, void* d_ws, size_t ws_size, hipStream_t stream) {
    const float* x = (const float*)d_in[0]; const float* meta = (const float*)d_in[1]; const float* w_in = (const float*)d_in[2]; const float* w_uk = (const float*)d_in[3];
    const float* w_uv = (const float*)d_in[4]; const float* kvw = (const float*)d_in[5]; const float* retw = (const float*)d_in[6]; const float* w_o = (const float*)d_in[7];
    const float* ln1g = (const float*)d_in[8]; const float* ln1b = (const float*)d_in[9]; const float* w_router = (const float*)d_in[10]; const float* rbias = (const float*)d_in[11];
    const float* w_gate = (const float*)d_in[12]; const float* w_up = (const float*)d_in[13]; const float* w_down = (const float*)d_in[14];
    const float* ws_gate = (const float*)d_in[15]; const float* ws_up = (const float*)d_in[16]; const float* ws_down = (const float*)d_in[17];
    const float* ln2g = (const float*)d_in[18]; const float* ln2b = (const float*)d_in[19];
    float* out = (float*)d_out;
    char* ws = (char*)d_ws; size_t o = 0;
    auto take = [&](size_t bytes) { char* p = ws + o; o += al(bytes); return p; };
    int* ctl = (int*)take(1 << 20);
    bf16_t* WinT = (bf16_t*)take((size_t)NL * DINP * D * 2);
    bf16_t* WoT = (bf16_t*)take((size_t)NL * D * D * 2);
    bf16_t* WukT = (bf16_t*)take((size_t)NL * 8 * 128 * 64 * 2);
    bf16_t* WuvT = (bf16_t*)take((size_t)NL * 8 * 64 * 128 * 2);
    bf16_t* W1T = (bf16_t*)take((size_t)65 * 512 * D * 2);
    bf16_t* W2T = (bf16_t*)take((size_t)65 * D * 256 * 2);
    float* hf = (float*)take((size_t)M * D * 4); bf16_t* hb = (bf16_t*)take((size_t)M * D * 2);
    char* U = take((size_t)RMAX * D * 2);
    float* proj = (float*)U; float* y1 = (float*)(U + (size_t)192 * 1024 * 1024); bf16_t* yrows = (bf16_t*)U;
    const size_t oA = o;
    bf16_t* qa = (bf16_t*)take((size_t)M * 512 * 2); bf16_t* ckv = (bf16_t*)take((size_t)M * 128 * 2); bf16_t* qi = (bf16_t*)take((size_t)M * 512 * 2);
    bf16_t* ki = (bf16_t*)take((size_t)M * 64 * 2); float* wi = (float*)take((size_t)M * 8 * 4);
    float* qr = (float*)take((size_t)M * 256 * 4); float* kr = (float*)take((size_t)M * 256 * 4); float* vr = (float*)take((size_t)M * 512 * 4); float* gr = (float*)take((size_t)M * 512 * 4);
    bf16_t* qlat = (bf16_t*)take((size_t)M * 1024 * 2); bf16_t* olat = (bf16_t*)take((size_t)M * 1024 * 2); float* oret = (float*)take((size_t)M * 512 * 4); bf16_t* mix = (bf16_t*)take((size_t)M * 1024 * 2);
    const size_t endA = o; o = oA;
    float* hf1 = (float*)take((size_t)M * D * 4); bf16_t* hb1 = (bf16_t*)take((size_t)M * D * 2); bf16_t* hdn = (bf16_t*)take((size_t)RMAX * DE * 2);
    int* list_tok = (int*)take((size_t)NE * M * 4); int* row_token = (int*)take((size_t)RMAX * 4);
    int* tok_e = (int*)take((size_t)M * 8 * 4); int* tok_pos = (int*)take((size_t)M * 8 * 4); float* tok_gate = (float*)take((size_t)M * 8 * 4);
    const size_t endB = o; const size_t need = endA > endB ? endA : endB;
    if (need > ws_size || n_in != 20) { fprintf(stderr, "kernel_launch: workspace too small (%zu > %zu) or bad n_in %d\n", need, ws_size, n_in); return; }
    int* cnt = ctl; int* off = ctl + 1024; int* ntiles = ctl + 1100; int* tile_expert = ctl + 2048;

    (void)hipMemsetAsync(ctl, 0, 1 << 20, stream);
    k_build_h0<<<(M * D / 4 + 255) / 256, 256, 0, stream>>>(x, meta, hf, hb);
    k_zero_bf16<<<(int)(((size_t)NL * DINP * D + 255) / 256), 256, 0, stream>>>(WinT, (size_t)NL * DINP * D);
    dim3 tb(32, 8);
    k_transpose<<<dim3((DIN + 31) / 32, D / 32, NL), tb, 0, stream>>>(w_in, WinT, D, DIN, (size_t)D * DIN, (size_t)DINP * D, D, DIN, 0, 0);
    k_transpose<<<dim3(D / 32, D / 32, NL), tb, 0, stream>>>(w_o, WoT, D, D, (size_t)D * D, (size_t)D * D, D, D, 0, 0);
    k_transpose<<<dim3(128 / 32, 64 / 32, NL * 8), tb, 0, stream>>>(w_uk, WukT, 64, 128, 64 * 128, 128 * 64, 64, 128, 0, 0);
    k_transpose<<<dim3(64 / 32, 128 / 32, NL * 8), tb, 0, stream>>>(w_uv, WuvT, 128, 64, 128 * 64, 64 * 128, 128, 64, 0, 0);
    for (int l = 0; l < NL; ++l) {
        k_transpose<<<dim3(DE / 32, D / 32, NE), tb, 0, stream>>>(w_gate + (size_t)l * NE * D * DE, W1T, D, DE, (size_t)D * DE, (size_t)512 * D, D, 32, 64, 0);
        k_transpose<<<dim3(DE / 32, D / 32, NE), tb, 0, stream>>>(w_up + (size_t)l * NE * D * DE, W1T, D, DE, (size_t)D * DE, (size_t)512 * D, D, 32, 64, 32);
        k_transpose<<<dim3(DE / 32, D / 32, 1), tb, 0, stream>>>(ws_gate + (size_t)l * D * DE, W1T + (size_t)NE * 512 * D, D, DE, 0, 0, D, 32, 64, 0);
        k_transpose<<<dim3(DE / 32, D / 32, 1), tb, 0, stream>>>(ws_up + (size_t)l * D * DE, W1T + (size_t)NE * 512 * D, D, DE, 0, 0, D, 32, 64, 32);
        k_transpose<<<dim3(D / 32, DE / 32, NE), tb, 0, stream>>>(w_down + (size_t)l * NE * DE * D, W2T, DE, D, (size_t)DE * D, (size_t)D * DE, DE, D, 0, 0);
        k_transpose<<<dim3(D / 32, DE / 32, 1), tb, 0, stream>>>(ws_down + (size_t)l * DE * D, W2T + (size_t)NE * D * DE, DE, D, 0, 0, DE, D, 0, 0);
        { GemmP p = mk_gemm(hb, D, 0, nullptr, WinT + (size_t)l * DINP * D, D, 0, M, DINP, D, nullptr, nullptr, 0);
          k_gemm<EpiF32, false><<<dim3(M / 128, DINP / 128, 1), 256, 0, stream>>>(p, EpiF32{proj, DINP, 0}); }
        k_post_proj<<<M, 256, 0, stream>>>(proj, kvw + (size_t)l * 128, qa, ckv, qi, ki, wi, qr, kr, vr, gr);
        { GemmP p = mk_gemm(qa, 512, 64, nullptr, WukT + (size_t)l * 8 * 128 * 64, 64, 128 * 64, M, 128, 64, nullptr, nullptr, 0);
          k_gemm<EpiBf16, false><<<dim3(M / 128, 1, 8), 256, 0, stream>>>(p, EpiBf16{qlat, 1024, 128, 0.125f, 0}); }
        k_attn_naive<<<M, 256, 0, stream>>>(qi, ki, wi, qlat, ckv, olat);
        { GemmP p = mk_gemm(olat, 1024, 128, nullptr, WuvT + (size_t)l * 8 * 64 * 128, 128, 64 * 128, M, 64, 128, nullptr, nullptr, 0);
          k_gemm<EpiBf16, false><<<dim3(M / 128, 1, 8), 256, 0, stream>>>(p, EpiBf16{mix, 1024, 64, 1.f, 0}); }
        k_ret_naive<<<BATCH * 4, 256, 0, stream>>>(qr, kr, vr, oret);
        k_ret_post<<<M * 4, 128, 0, stream>>>(oret, gr, retw + (size_t)l * 512, mix);
        { GemmP p = mk_gemm(mix, D, 0, nullptr, WoT + (size_t)l * D * D, D, 0, M, D, D, nullptr, nullptr, 0);
          k_gemm<EpiResid, false><<<dim3(M / 128, D / 128, 1), 256, 0, stream>>>(p, EpiResid{hf, y1, DN_ALPHA, 0}); }
        k_ln1_route<<<M, 256, 0, stream>>>(y1, ln1g + (size_t)l * D, ln1b + (size_t)l * D, w_router + (size_t)l * D * NE, rbias + (size_t)l * NE, hf1, hb1, cnt + l * 64, list_tok, tok_e, tok_pos, tok_gate);
        k_moe_offsets<<<1, 64, 0, stream>>>(cnt + l * 64, off, tile_expert, ntiles);
        k_moe_scatter<<<dim3(NE + 1, (M + 255) / 256), 256, 0, stream>>>(cnt + l * 64, off, list_tok, row_token);
        { GemmP p = mk_gemm(hb1, D, 0, row_token, W1T, D, 0, RMAX, 512, D, tile_expert, ntiles, (size_t)512 * D);
          k_gemm<EpiSwiglu, true><<<dim3(MAXTILES, 512 / 128, 1), 256, 0, stream>>>(p, EpiSwiglu{hdn}); }
        { GemmP p = mk_gemm(hdn, DE, 0, nullptr, W2T, DE, 0, RMAX, D, DE, tile_expert, ntiles, (size_t)D * DE);
          k_gemm<EpiBf16, false><<<dim3(MAXTILES, D / 128, 1), 256, 0, stream>>>(p, EpiBf16{yrows, D, 0, 1.f, 0}); }
        k_combine_ln2<<<M, 256, 0, stream>>>(hf1, yrows, off, tok_e, tok_pos, tok_gate, ln2g + (size_t)l * D, ln2b + (size_t)l * D, hf, hb, l == NL - 1 ? out : nullptr);
    }
}
```

```cpp
#include <hip/hip_runtime.h>
#include <hip/hip_cooperative_groups.h>
#include <stdint.h>
#include <stdio.h>
#include <string.h>
namespace cg = cooperative_groups;

typedef unsigned short bf16_t;
typedef short bf16x8 __attribute__((ext_vector_type(8)));
typedef float f32x16 __attribute__((ext_vector_type(16)));
typedef float f32x4 __attribute__((ext_vector_type(4)));
typedef float f32x2 __attribute__((ext_vector_type(2)));
typedef unsigned u32x4 __attribute__((ext_vector_type(4)));
typedef unsigned u32x2 __attribute__((ext_vector_type(2)));
#define LAS __attribute__((address_space(3)))

constexpr int D = 1024, BATCH = 8, SEQ = 2048, NMETA = 16, T = SEQ + NMETA, NL = 4;
constexpr int MR = BATCH * SEQ, MT = MR + NMETA, MP = 65 * 256, KVR = BATCH * T;
constexpr int DIN = 2760, DINP = 2816;
constexpr int NE = 64, TOPK = 8, DE = 256;
constexpr int NSEL = 256;
constexpr int C_QA = 0, C_CKV = 512, C_QI = 640, C_KI = 1152, C_WI = 1216, C_QR = 1224, C_KR = 1480, C_VR = 1736, C_GR = 2248;
constexpr float DN_ALPHA = 1.681792830507429f;
constexpr float EPS = 1e-6f;

__device__ __forceinline__ int fresh_tid() { int t = threadIdx.x; asm volatile("" : "+v"(t)); return t; }
__device__ __forceinline__ int fresh_bid() { int b = blockIdx.x; asm volatile("" : "+s"(b)); return b; }
__device__ __forceinline__ bf16_t f2bf(float f) { unsigned u = __float_as_uint(f); return (bf16_t)((u + 0x7fffu + ((u >> 16) & 1u)) >> 16); }
__device__ __forceinline__ float bf2f(bf16_t h) { return __uint_as_float(((unsigned)h) << 16); }
__device__ __forceinline__ unsigned pk2(float lo, float hi) { return (unsigned)f2bf(lo) | ((unsigned)f2bf(hi) << 16); }
__device__ __forceinline__ u32x4 pk8(f32x4 a, f32x4 b) { u32x4 w; w.x = pk2(a[0], a[1]); w.y = pk2(a[2], a[3]); w.z = pk2(b[0], b[1]); w.w = pk2(b[2], b[3]); return w; }
__device__ __forceinline__ float ret_log2_gamma(int hh) { const float xh = -3.4657359027997265f + (float)hh * (-0.9241962407465937f); return log2f(1.f - expf(xh)); }
__device__ __forceinline__ float siluf(float g) { return g / (1.f + __expf(-g)); }
__host__ __device__ __forceinline__ int win_src_col(int n) {
    if (n < 512) return C_QA + n;
    if (n < 1024) return C_QI + (n - 512);
    if (n < 1536) { int c = n - 1024; const int isk = c >> 8; c &= 255; const int half = c >> 7, cc = c & 127, hh = cc >> 5, i = cc & 31; return (isk ? C_KR : C_QR) + hh * 64 + half * 32 + i; }
    if (n < 2048) return C_VR + (n - 1536);
    if (n < 2560) return C_GR + (n - 2048);
    const int c = n - 2560; if (c < 128) return C_CKV + c; if (c < 192) return C_KI + (c - 128); if (c < 200) return C_WI + (c - 192); return -1;
}
#define GAS __attribute__((address_space(1)))

#define XB_TMO      128
#define XB_XCNT(j)  (256  + 64 * (j))
#define XB_XSUB(j)  (1280 + 64 * (j))
#define XB_XGEN(j)  (2304 + 64 * (j))
#define XB_TOP      3328
#define XB_TOPGEN   3392
#define XCD_BAR_WORDS 3456
#define XB_SPIN_CAP (1u << 18)

__device__ __forceinline__ unsigned xb_ld(unsigned* p)              { return __hip_atomic_load(p, __ATOMIC_RELAXED, __HIP_MEMORY_SCOPE_AGENT); }
__device__ __forceinline__ unsigned xb_add(unsigned* p, unsigned v) { return __hip_atomic_fetch_add(p, v, __ATOMIC_RELAXED, __HIP_MEMORY_SCOPE_AGENT); }
__device__ __forceinline__ unsigned xb_xcc_id() { return (unsigned)__builtin_amdgcn_s_getreg((3 << 11) | 20) & 0xFu; }
#define XB_SPIN(cond, bar) do { unsigned _sp = 0; while (cond) { __builtin_amdgcn_s_sleep(1); \
    if ((++_sp & 255u) == 0u) { if (xb_ld(&(bar)[XB_TMO])) break; if (_sp > XB_SPIN_CAP) { atomicAdd(&(bar)[XB_TMO], 1u); break; } } } } while (0)

struct XcdBarrier {
    unsigned* bar; unsigned x;
    volatile LAS unsigned* st;
};

__device__ __forceinline__ XcdBarrier xcd_barrier_post(unsigned* bar, volatile LAS unsigned* st) {
    XcdBarrier b; b.bar = bar; b.x = xb_xcc_id(); b.st = st;
    if (threadIdx.x == 0) (void)xb_add(&bar[XB_XCNT(b.x)], 1u);
    return b;
}
__device__ __forceinline__ void xcd_barrier_complete(unsigned* bar, unsigned x, unsigned& nloc, unsigned& nx) {
    const unsigned G = gridDim.x * gridDim.y * gridDim.z;
    unsigned sum, cnt, mine, sp = 0u;
    for (;;) {
        sum = 0u; cnt = 0u; mine = 0u;
#pragma unroll
        for (unsigned j = 0; j < 16; ++j) { const unsigned c = xb_ld(&bar[XB_XCNT(j)]); sum += c; cnt += (c > 0u) ? 1u : 0u; mine = (j == x) ? c : mine; }
        if (sum == G) break;
        __builtin_amdgcn_s_sleep(1);
        if ((++sp & 255u) == 0u) { if (xb_ld(&bar[XB_TMO])) break; if (sp > XB_SPIN_CAP) { atomicAdd(&bar[XB_TMO], 1u); break; } }
    }
    nloc = mine > 0u ? mine : 1u; nx = cnt > 0u ? cnt : 1u;
}

__device__ __forceinline__ void xcd_barrier(const XcdBarrier& b) {
    asm volatile("s_waitcnt vmcnt(0)" ::: "memory");
    __syncthreads();
    if (threadIdx.x == 0) {
        unsigned* bar = b.bar;
        __builtin_amdgcn_s_waitcnt(0);
        unsigned nloc = b.st[0], nx = b.st[1];
        if (nloc == 0u) { xcd_barrier_complete(bar, b.x, nloc, nx); b.st[0] = nloc; b.st[1] = nx; }
        const unsigned old = xb_add(&bar[XB_XSUB(b.x)], 1u);
        const unsigned gen = old / nloc;
        if (old + 1u == (gen + 1u) * nloc) {
            __builtin_amdgcn_fence(__ATOMIC_RELEASE, "agent");
            asm volatile("s_waitcnt vmcnt(0)" ::: "memory");
            const unsigned og = xb_add(&bar[XB_TOP], 1u);
            const unsigned tg = og / nx;
            if (og + 1u == (tg + 1u) * nx) xb_add(&bar[XB_TOPGEN], 1u);
            else XB_SPIN(xb_ld(&bar[XB_TOPGEN]) == tg, bar);
            __builtin_amdgcn_fence(__ATOMIC_ACQUIRE, "agent");
            xb_add(&bar[XB_XGEN(b.x)], 1u);
            asm volatile("s_waitcnt vmcnt(0)" ::: "memory");
        } else {
            XB_SPIN(xb_ld(&bar[XB_XGEN(b.x)]) == gen, bar);
            __builtin_amdgcn_fence(__ATOMIC_ACQUIRE, "agent");
            asm volatile("s_waitcnt vmcnt(0)" ::: "memory");
        }
    }
    __syncthreads();
}

namespace pg8 {
#define PG8_LAS __attribute__((address_space(3)))
constexpr int BM = 256, BK = 64, HALF = 128, HTB = HALF * BK * 2  , STAGE_BYTES = 8 * HTB;

__host__ __device__ __forceinline__ int lds_byte(int r, int c) { const int st = (r >> 4) * 2 + (c >> 5), rr = r & 15, cc = c & 31, ob = rr * 64 + cc * 2; return st * 1024 + (ob ^ (((ob >> 9) & 1) << 5)); }
__host__ __device__ __forceinline__ void stage_rc(int b, int& R, int& C) { const int st = b / 1024, sb = b % 1024, swz = sb ^ (((sb >> 9) & 1) << 5); R = (st >> 1) * 16 + swz / 64; C = (st & 1) * 32 + (swz % 64) / 2; }
__host__ __device__ __forceinline__ int perm32(int rho) { const int n = rho >> 4, i = rho & 15; return 8 * (i >> 2) + 4 * n + (i & 3); }

struct Unit { int pm, pn, aux, lt, nval; };

template <class Epi, class Sched, bool ALIGN_EPI>
__device__ __forceinline__ void gemm_phase(PG8_LAS unsigned char* lds, const int K, const Sched& S, const Epi& E) {
    const int tid = fresh_tid(), wid = __builtin_amdgcn_readfirstlane(tid >> 6), lane = tid & 63, wr = wid >> 2, wc = wid & 3, fr = lane & 15, fq = lane >> 4;
    const int nt = K / BK;
    const unsigned rowb = (unsigned)K * 2u;
    int Rr[2]; unsigned Cb[2], voffB[2];
#pragma unroll
    for (int i = 0; i < 2; ++i) { int R, C; stage_rc(tid * 16 + i * 8192, R, C); const int Rb = Epi::PERM ? ((R & ~31) + perm32(R & 31)) : R;
        Rr[i] = R; Cb[i] = (unsigned)C * 2u; voffB[i] = (unsigned)Rb * rowb + (unsigned)C * 2u; }
    const size_t kstep = (size_t)(BK * 2);
    const size_t hstep = (size_t)HALF * K * 2;
    const unsigned ldsw = (unsigned)wid * 1024u;
    const int aoff = lds_byte(wr * 64 + fr, fq * 8), boff = lds_byte(wc * 32 + fr, fq * 8);
#define PG8_SA(b, h) (((b) * 2 + (h)) * HTB)
#define PG8_SB(b, h) ((4 + (b) * 2 + (h)) * HTB)
#define PG8_STAGE(bufoff, gbase, voff) do { _Pragma("unroll") for (int _i = 0; _i < 2; ++_i) \
        __builtin_amdgcn_global_load_lds((const unsigned*)((const char*)(gbase) + (voff)[_i]), (PG8_LAS unsigned*)(lds + (bufoff) + ldsw + _i * 8192), 16, 0, 0); } while (0)
#define PG8_SETA(v, u) do { if constexpr (Sched::GATHER) { _Pragma("unroll") for (int _h = 0; _h < 2; ++_h) _Pragma("unroll") for (int _i = 0; _i < 2; ++_i) \
            v[_h][_i] = (unsigned)S.arow(u, 128 * _h + Rr[_i]) * rowb + Cb[_i]; } \
        else { _Pragma("unroll") for (int _h = 0; _h < 2; ++_h) _Pragma("unroll") for (int _i = 0; _i < 2; ++_i) v[_h][_i] = (unsigned)(128 * _h + Rr[_i]) * rowb + Cb[_i]; } } while (0)
#define PG8_LDA(dst, b, h) do { _Pragma("unroll") for (int m = 0; m < 4; ++m) _Pragma("unroll") for (int k = 0; k < 2; ++k) dst[m][k] = *(const PG8_LAS bf16x8*)(lds + PG8_SA(b, h) + aoff + m * 2048 + k * 1024); } while (0)
#define PG8_LDB(dst, b, h) do { _Pragma("unroll") for (int n = 0; n < 2; ++n) _Pragma("unroll") for (int k = 0; k < 2; ++k) dst[n][k] = *(const PG8_LAS bf16x8*)(lds + PG8_SB(b, h) + boff + n * 2048 + k * 1024); } while (0)
#define PG8_MMA(ai, bj, At, Bt) do { __builtin_amdgcn_s_setprio(1); _Pragma("unroll") for (int m = 0; m < 4; ++m) _Pragma("unroll") for (int n = 0; n < 2; ++n) _Pragma("unroll") for (int k = 0; k < 2; ++k) \
        acc[ai][bj][m][n] = __builtin_amdgcn_mfma_f32_16x16x32_bf16(Bt[n][k], At[m][k], acc[ai][bj][m][n], 0, 0, 0); __builtin_amdgcn_s_setprio(0); } while (0)
#define PG8_WAIT_V(n) asm volatile("s_waitcnt vmcnt(" #n ")" ::: "memory")
#define PG8_WAIT_L(n) asm volatile("s_waitcnt lgkmcnt(" #n ")" ::: "memory")
#define PG8_BAR __builtin_amdgcn_s_barrier()
#define PG8_SCHED __builtin_amdgcn_sched_barrier(0)
    Unit cur, nxt; int ui = 0;
    if (!S.next(0, cur)) return;
    f32x4 acc[2][2][4][2];
#pragma unroll
    for (int a = 0; a < 2; ++a)
#pragma unroll
        for (int b = 0; b < 2; ++b)
#pragma unroll
            for (int m = 0; m < 4; ++m)
#pragma unroll
                for (int n = 0; n < 2; ++n) acc[a][b][m][n] = (f32x4){0.f, 0.f, 0.f, 0.f};
    bf16x8 At[4][2], B0[2][2], B1[2][2];
    unsigned vAc[2][2], vAn[2][2];
    const char* cA = S.a_base(cur); const char* cB = S.b_base(cur);
    PG8_SETA(vAc, cur);
    PG8_STAGE(PG8_SB(0, 0), cB, voffB); PG8_STAGE(PG8_SB(0, 1), cB + hstep, voffB); PG8_STAGE(PG8_SA(0, 0), cA, vAc[0]); PG8_STAGE(PG8_SA(0, 1), cA, vAc[1]);
    if (wr == 1) PG8_BAR;
    PG8_WAIT_V(2); PG8_BAR;
    PG8_STAGE(PG8_SB(1, 0), cB + kstep, voffB); PG8_STAGE(PG8_SA(1, 0), cA + kstep, vAc[0]); PG8_STAGE(PG8_SB(1, 1), cB + hstep + kstep, voffB);
    PG8_WAIT_V(6); PG8_BAR;
    for (;;) {
        const bool has_next = S.next(ui + 1, nxt);
        const char* nA = has_next ? S.a_base(nxt) : cA; const char* nB = has_next ? S.b_base(nxt) : cB;
        if (has_next) { PG8_SETA(vAn, nxt); } else {
#pragma unroll
            for (int h = 0; h < 2; ++h)
#pragma unroll
                for (int i = 0; i < 2; ++i) vAn[h][i] = vAc[h][i]; }
#pragma unroll 1
        for (int t = 0; t < nt; t += 2) {
            const bool last = (t == nt - 2);
            const char* a1 = cA + (size_t)(t + 1) * kstep;
            const char* a2 = last ? nA : cA + (size_t)(t + 2) * kstep; const char* b2 = last ? nB : cB + (size_t)(t + 2) * kstep;
            const char* a3 = a2 + kstep; const char* b3 = b2 + kstep;
            unsigned v2[2][2];
#pragma unroll
            for (int h = 0; h < 2; ++h)
#pragma unroll
                for (int i = 0; i < 2; ++i) v2[h][i] = last ? vAn[h][i] : vAc[h][i];
            PG8_LDB(B0, 0, 0); PG8_LDB(B1, 0, 1); PG8_SCHED; PG8_LDA(At, 0, 0); PG8_STAGE(PG8_SA(1, 1), a1, vAc[1]);
            PG8_WAIT_V(8); PG8_WAIT_L(0); PG8_BAR; PG8_MMA(0, 0, At, B0); PG8_MMA(0, 1, At, B1); PG8_BAR; PG8_SCHED;
            PG8_LDA(At, 0, 1); PG8_STAGE(PG8_SB(0, 0), b2, voffB); PG8_STAGE(PG8_SB(0, 1), b2 + hstep, voffB); PG8_STAGE(PG8_SA(0, 0), a2, v2[0]);
            PG8_WAIT_V(8); PG8_WAIT_L(0); PG8_BAR; PG8_MMA(1, 0, At, B0); PG8_MMA(1, 1, At, B1); PG8_BAR; PG8_SCHED;
            PG8_LDB(B0, 1, 0); PG8_LDB(B1, 1, 1); PG8_SCHED; PG8_LDA(At, 1, 0); PG8_STAGE(PG8_SA(0, 1), a2, v2[1]);
            PG8_WAIT_V(8); PG8_WAIT_L(0); PG8_BAR; PG8_MMA(0, 0, At, B0); PG8_MMA(0, 1, At, B1); PG8_BAR; PG8_SCHED;
            PG8_LDA(At, 1, 1); PG8_STAGE(PG8_SB(1, 0), b3, voffB); PG8_STAGE(PG8_SB(1, 1), b3 + hstep, voffB); PG8_STAGE(PG8_SA(1, 0), a3, v2[0]);
            PG8_WAIT_V(8); PG8_WAIT_L(0); PG8_BAR; PG8_MMA(1, 0, At, B0); PG8_MMA(1, 1, At, B1); PG8_BAR; PG8_SCHED;
        }
        if constexpr (ALIGN_EPI) { if (wr == 0) PG8_BAR; }
        E(acc, cur, wr, wc, fr, fq);
        if (!has_next) break;
#pragma unroll
        for (int a = 0; a < 2; ++a)
#pragma unroll
            for (int b = 0; b < 2; ++b)
#pragma unroll
                for (int m = 0; m < 4; ++m)
#pragma unroll
                    for (int n = 0; n < 2; ++n) acc[a][b][m][n] = (f32x4){0.f, 0.f, 0.f, 0.f};
        cur = nxt; cA = nA; cB = nB; ++ui;
#pragma unroll
        for (int h = 0; h < 2; ++h)
#pragma unroll
            for (int i = 0; i < 2; ++i) vAc[h][i] = vAn[h][i];
        if constexpr (ALIGN_EPI) { if (wr == 1) PG8_BAR; }
    }
    PG8_WAIT_V(0);
    if constexpr (!ALIGN_EPI) { if (wr == 0) PG8_BAR; }
    PG8_BAR;
#undef PG8_SA
#undef PG8_SB
#undef PG8_STAGE
#undef PG8_SETA
#undef PG8_LDA
#undef PG8_LDB
#undef PG8_MMA
#undef PG8_WAIT_V
#undef PG8_WAIT_L
#undef PG8_BAR
#undef PG8_SCHED
}
}
constexpr int NXCD = 8, WGM = 8;
struct DenseSched {
    static constexpr bool GATHER = false;
    const char* A; const char* Bt; size_t tstep; int nM, nN, nwg, G, c;
    __device__ __forceinline__ void init(const bf16_t* A_, const bf16_t* Bt_, int K, int nM_, int nN_, int G_, int c_) { A = (const char*)A_; Bt = (const char*)Bt_; tstep = (size_t)256 * K * 2; nM = nM_; nN = nN_; nwg = nM * nN; G = G_; c = c_; }
    __device__ __forceinline__ bool next(int i, pg8::Unit& u) const {
        const long L = (long)i * G + c; if (L >= nwg) return false;
        int wgid = (int)L; { const int q = nwg / NXCD, r = nwg % NXCD, xcd = wgid % NXCD, off = wgid / NXCD; wgid = (xcd < r ? xcd * (q + 1) : r * (q + 1) + (xcd - r) * q) + off; }
        const int nig = WGM * nN, gid = wgid / nig, fm = gid * WGM, gsz = (nM - fm) < WGM ? (nM - fm) : WGM;
        u.pm = fm + ((wgid % nig) % gsz); u.pn = (wgid % nig) / gsz; u.aux = 0; u.lt = 0; u.nval = 256; return true;
    }
    __device__ __forceinline__ const char* a_base(const pg8::Unit& u) const { return A + (size_t)u.pm * tstep; }
    __device__ __forceinline__ const char* b_base(const pg8::Unit& u) const { return Bt + (size_t)u.pn * tstep; }
    __device__ __forceinline__ int arow(const pg8::Unit&, int i) const { return i; }
};

__device__ __forceinline__ void st16(bf16_t* p, u32x4 v) { *(u32x4*)p = v; }
struct EpiInProj {
    static constexpr bool PERM = true;
    bf16_t *qa, *qi, *qr, *kr, *vr, *sg, *ckvr, *ki; float* wi; const f32x2* rot;
    __device__ __forceinline__ void operator()(const f32x4 (&acc)[2][2][4][2], const pg8::Unit& u, int wr, int wc, int fr, int fq) const {
        const int pn = u.pn, cw = 32 * wc + 8 * fq;
        const float lg = ret_log2_gamma(wc);
#pragma unroll
        for (int ai = 0; ai < 2; ++ai)
#pragma unroll
            for (int m = 0; m < 4; ++m) {
                const int r = u.pm * 256 + ai * 128 + wr * 64 + m * 16 + fr;
                if (r >= MT) continue;
                const int p = r < MR ? NMETA + (r & (SEQ - 1)) : r - MR;
                const int nrep = r < MR ? 1 : BATCH;
                const int kv0 = r < MR ? (r >> 11) * T + p : p;
                if (pn < 2) { st16(qa + (size_t)r * 512 + 256 * pn + cw, pk8(acc[ai][0][m][0], acc[ai][0][m][1])); st16(qa + (size_t)r * 512 + 256 * pn + 128 + cw, pk8(acc[ai][1][m][0], acc[ai][1][m][1])); }
                else if (pn < 4) { st16(qi + (size_t)r * 512 + 256 * (pn - 2) + cw, pk8(acc[ai][0][m][0], acc[ai][0][m][1])); st16(qi + (size_t)r * 512 + 256 * (pn - 2) + 128 + cw, pk8(acc[ai][1][m][0], acc[ai][1][m][1])); }
                else if (pn < 6) {
                    const int nl = (p + 112) & 127;
                    const float sc = pn == 4 ? exp2f((float)nl * lg) : 0.125f * exp2f(-(float)nl * lg);
                    f32x4 o1[2], o2[2];
#pragma unroll
                    for (int n = 0; n < 2; ++n)
#pragma unroll
                        for (int j = 0; j < 4; ++j) { const f32x2 cs = rot[p * 32 + 8 * fq + 4 * n + j]; const float x1 = acc[ai][0][m][n][j], x2 = acc[ai][1][m][n][j];
                            o1[n][j] = (x1 * cs.x - x2 * cs.y) * sc; o2[n][j] = (x1 * cs.y + x2 * cs.x) * sc; }
                    const u32x4 w1 = pk8(o1[0], o1[1]), w2 = pk8(o2[0], o2[1]);
                    if (pn == 4) { st16(qr + (size_t)r * 256 + wc * 64 + 8 * fq, w1); st16(qr + (size_t)r * 256 + wc * 64 + 32 + 8 * fq, w2); }
                    else for (int rep = 0; rep < nrep; ++rep) { bf16_t* d = kr + (size_t)(kv0 + rep * T) * 256 + wc * 64 + 8 * fq; st16(d, w1); st16(d + 32, w2); }
                }
                else if (pn < 8) { const u32x4 w1 = pk8(acc[ai][0][m][0], acc[ai][0][m][1]), w2 = pk8(acc[ai][1][m][0], acc[ai][1][m][1]);
                    for (int rep = 0; rep < nrep; ++rep) { bf16_t* d = vr + (size_t)(kv0 + rep * T) * 512 + 256 * (pn - 6) + cw; st16(d, w1); st16(d + 128, w2); } }
                else if (pn < 10) {
                    f32x4 s[2][2];
#pragma unroll
                    for (int bj = 0; bj < 2; ++bj)
#pragma unroll
                        for (int n = 0; n < 2; ++n)
#pragma unroll
                            for (int j = 0; j < 4; ++j) s[bj][n][j] = siluf(acc[ai][bj][m][n][j]);
                    st16(sg + (size_t)r * 512 + 256 * (pn - 8) + cw, pk8(s[0][0], s[0][1])); st16(sg + (size_t)r * 512 + 256 * (pn - 8) + 128 + cw, pk8(s[1][0], s[1][1]));
                }
                else {
                    const u32x4 w1 = pk8(acc[ai][0][m][0], acc[ai][0][m][1]), w2 = pk8(acc[ai][1][m][0], acc[ai][1][m][1]);
                    for (int rep = 0; rep < nrep; ++rep) { st16(ckvr + (size_t)(kv0 + rep * T) * 128 + cw, w1); if (wc < 2) st16(ki + (size_t)(kv0 + rep * T) * 64 + cw, w2); }
                    if (wc == 2 && fq == 0) { *(f32x4*)(wi + (size_t)r * 8) = acc[ai][1][m][0] * 0.35355339059327373f; *(f32x4*)(wi + (size_t)r * 8 + 4) = acc[ai][1][m][1] * 0.35355339059327373f; }
                }
            }
    }
};
struct InProjArgs { const bf16_t* hb; const bf16_t* WinT; bf16_t *qa, *qi, *qr, *kr, *vr, *sg, *ckvr, *ki; float* wi; const f32x2* rot; };
__device__ __forceinline__ void phase_inproj(LAS unsigned char* lds, const InProjArgs& a) {
    DenseSched S; S.init(a.hb, a.WinT, D, MP / 256, DINP / 256, (int)gridDim.x, fresh_bid());
    EpiInProj E; E.qa = a.qa; E.qi = a.qi; E.qr = a.qr; E.kr = a.kr; E.vr = a.vr; E.sg = a.sg; E.ckvr = a.ckvr; E.ki = a.ki; E.wi = a.wi; E.rot = a.rot;
    pg8::gemm_phase<EpiInProj, DenseSched, true>(lds, D, S, E);
}
struct EpiOutProj {
    static constexpr bool PERM = false;
    const bf16_t* h; float* y;
    __device__ __forceinline__ void operator()(const f32x4 (&acc)[2][2][4][2], const pg8::Unit& u, int wr, int wc, int fr, int fq) const {
#pragma unroll
        for (int ai = 0; ai < 2; ++ai)
#pragma unroll
            for (int m = 0; m < 4; ++m) {
                const int r = u.pm * 256 + ai * 128 + wr * 64 + m * 16 + fr; if (r >= MT) continue;
#pragma unroll
                for (int bj = 0; bj < 2; ++bj)
#pragma unroll
                    for (int n = 0; n < 2; ++n) { const size_t i = (size_t)r * D + u.pn * 256 + bj * 128 + wc * 32 + n * 16 + fq * 4; const u32x2 hv = *(const u32x2*)(h + i);
                        const f32x4 hf4 = (f32x4){bf2f((bf16_t)(hv.x & 0xffff)), bf2f((bf16_t)(hv.x >> 16)), bf2f((bf16_t)(hv.y & 0xffff)), bf2f((bf16_t)(hv.y >> 16))}; *(f32x4*)(y + i) = hf4 * DN_ALPHA + acc[ai][bj][m][n]; }
            }
    }
};
struct OutProjArgs { const bf16_t* mix; const bf16_t* WoT; const bf16_t* h; float* y; };
__device__ __forceinline__ void phase_outproj(LAS unsigned char* lds, const OutProjArgs& a, int nM) {
    DenseSched S; S.init(a.mix, a.WoT, D, nM, D / 256, (int)gridDim.x, fresh_bid());
    EpiOutProj E; E.h = a.h; E.y = a.y;
    pg8::gemm_phase<EpiOutProj, DenseSched, true>(lds, D, S, E);
}

constexpr int MAXT = 644;
constexpr int RMAX = MAXT * 256;
__device__ __forceinline__ int xcd_vcu(int bx, int G) { return (G % 8 == 0) ? (bx % 8) * (G / 8) + bx / 8 : bx; }
constexpr int LSTRIDE = MP;
constexpr int L_TF = 159744;
__device__ __forceinline__ void moe_tile_prefix(LAS unsigned char* lds, const int* cnt) {
    LAS int* tf = (LAS int*)(lds + L_TF);
    __syncthreads();
    const int tid_ = fresh_tid();
    if (tid_ < 64) {
        const int e = tid_; const int nt = (cnt[e] + 255) >> 8; int incl = nt;
#pragma unroll
        for (int o = 1; o < 64; o <<= 1) { const int v = __shfl_up(incl, o); if (e >= o) incl += v; }
        tf[e] = incl - nt; if (e == 63) { tf[64] = incl; tf[65] = incl + MP / 256; }
    }
    __syncthreads();
}
template <bool GATH, int NPN>
struct MoeSched {
    static constexpr bool GATHER = GATH;
    const char* A; const char* Wt; const int* list_tok; const int* cnt; LAS const int* tf; size_t estride, tstepB, tstepA; int nunits, G, vcu;
    __device__ __forceinline__ bool next(int i, pg8::Unit& u) const {
        const int L = i * G + vcu; if (L >= nunits) return false; u.pm = L / NPN; u.pn = L % NPN;
        int lo = 0, hi = 64;
        while (lo < hi) { const int mid = (lo + hi + 1) >> 1; if (tf[mid] <= u.pm) lo = mid; else hi = mid - 1; }
        u.aux = lo; u.lt = 0; u.nval = 256;
        if constexpr (GATH) { u.lt = u.pm - tf[lo]; const int c = lo < 64 ? cnt[lo] : MT; const int rem = c - 256 * u.lt; u.nval = rem < 256 ? rem : 256; }
        return true;
    }
    __device__ __forceinline__ const char* a_base(const pg8::Unit& u) const { return GATH ? A : A + (size_t)u.pm * tstepA; }
    __device__ __forceinline__ const char* b_base(const pg8::Unit& u) const { return Wt + (size_t)u.aux * estride + (size_t)u.pn * tstepB; }
    __device__ __forceinline__ int arow(const pg8::Unit& u, int i) const { if (i >= u.nval) return 0; return u.aux < 64 ? list_tok[(size_t)u.aux * LSTRIDE + u.lt * 256 + i] : u.lt * 256 + i; }
};
struct EpiSwiglu8 {
    static constexpr bool PERM = true;
    bf16_t* hdn;
    __device__ __forceinline__ void operator()(const f32x4 (&acc)[2][2][4][2], const pg8::Unit& u, int wr, int wc, int fr, int fq) const {
#pragma unroll
        for (int ai = 0; ai < 2; ++ai)
#pragma unroll
            for (int m = 0; m < 4; ++m) {
                const size_t r = (size_t)u.pm * 256 + ai * 128 + wr * 64 + m * 16 + fr;
                f32x4 s[2];
#pragma unroll
                for (int n = 0; n < 2; ++n)
#pragma unroll
                    for (int j = 0; j < 4; ++j) s[n][j] = siluf(acc[ai][0][m][n][j]) * acc[ai][1][m][n][j];
                st16(hdn + r * DE + u.pn * 128 + wc * 32 + fq * 8, pk8(s[0], s[1]));
            }
    }
};
struct EpiRows8 {
    static constexpr bool PERM = true;
    bf16_t* y;
    __device__ __forceinline__ void operator()(const f32x4 (&acc)[2][2][4][2], const pg8::Unit& u, int wr, int wc, int fr, int fq) const {
#pragma unroll
        for (int ai = 0; ai < 2; ++ai)
#pragma unroll
            for (int m = 0; m < 4; ++m) {
                const size_t r = (size_t)u.pm * 256 + ai * 128 + wr * 64 + m * 16 + fr;
#pragma unroll
                for (int bj = 0; bj < 2; ++bj) st16(y + r * D + u.pn * 256 + bj * 128 + wc * 32 + fq * 8, pk8(acc[ai][bj][m][0], acc[ai][bj][m][1]));
            }
    }
};
struct MoeArgs { const bf16_t* hb1; const bf16_t* W1T; const bf16_t* W2T; bf16_t* hdn; bf16_t* yrows; const int* list_tok; const int* cnt; };
__device__ __forceinline__ void phase_moe1(LAS unsigned char* lds, const MoeArgs& a) {
    moe_tile_prefix(lds, a.cnt);
    MoeSched<true, 2> S; S.A = (const char*)a.hb1; S.Wt = (const char*)a.W1T; S.list_tok = a.list_tok; S.cnt = a.cnt; S.tf = (LAS const int*)(lds + L_TF); S.estride = (size_t)512 * D * 2; S.tstepB = (size_t)256 * D * 2; S.tstepA = 0;
    S.nunits = S.tf[65] * 2; S.G = (int)gridDim.x; S.vcu = xcd_vcu(fresh_bid(), (int)gridDim.x);
    EpiSwiglu8 E; E.hdn = a.hdn;
    pg8::gemm_phase<EpiSwiglu8, MoeSched<true, 2>, true>(lds, D, S, E);
}
__device__ __forceinline__ void phase_moe2(LAS unsigned char* lds, const MoeArgs& a) {
    moe_tile_prefix(lds, a.cnt);
    MoeSched<false, 4> S; S.A = (const char*)a.hdn; S.Wt = (const char*)a.W2T; S.list_tok = a.list_tok; S.cnt = a.cnt; S.tf = (LAS const int*)(lds + L_TF); S.estride = (size_t)D * DE * 2; S.tstepB = (size_t)256 * DE * 2; S.tstepA = (size_t)256 * DE * 2;
    S.nunits = S.tf[65] * 4; S.G = (int)gridDim.x; S.vcu = xcd_vcu(fresh_bid(), (int)gridDim.x);
    EpiRows8 E; E.y = a.yrows;
    pg8::gemm_phase<EpiRows8, MoeSched<false, 4>, true>(lds, DE, S, E);
}
__device__ __forceinline__ float wave_sum(float v) {
#pragma unroll
    for (int o = 1; o < 64; o <<= 1) v += __shfl_xor(v, o);
    return v;
}
__device__ __forceinline__ void unpack8(u32x4 w, float* f) { f[0] = bf2f((bf16_t)(w.x & 0xffff)); f[1] = bf2f((bf16_t)(w.x >> 16)); f[2] = bf2f((bf16_t)(w.y & 0xffff)); f[3] = bf2f((bf16_t)(w.y >> 16));
    f[4] = bf2f((bf16_t)(w.z & 0xffff)); f[5] = bf2f((bf16_t)(w.z >> 16)); f[6] = bf2f((bf16_t)(w.w & 0xffff)); f[7] = bf2f((bf16_t)(w.w >> 16)); }

struct Pre2Args { const bf16_t* ckvr; const float* kvw; bf16_t* ckv; const bf16_t* qa; const bf16_t* WukT; bf16_t* qlat; };
__device__ __forceinline__ void phase_pre2(const Pre2Args& a) {
    const int tid = fresh_tid(), lane = tid & 63, w = tid >> 6, gw = fresh_bid() * 8 + w, ngw = gridDim.x * 8;
    for (int row = gw; row < KVR; row += ngw) {
        const unsigned x = *(const unsigned*)(a.ckvr + (size_t)row * 128 + lane * 2);
        const float c0 = bf2f((bf16_t)(x & 0xffff)), c1 = bf2f((bf16_t)(x >> 16));
        const float rs = rsqrtf(wave_sum(c0 * c0 + c1 * c1) * (1.f / 128.f) + EPS);
        *(unsigned*)(a.ckv + (size_t)row * 128 + lane * 2) = pk2(c0 * rs * a.kvw[lane * 2], c1 * rs * a.kvw[lane * 2 + 1]);
    }
    const int r32 = lane & 31, hi = lane >> 5;
    for (int u = gw; u < ((MT + 31) / 32) * 8; u += ngw) {
        const int rt = u >> 3, h = u & 7; const int row = rt * 32 + r32, rowc = row < MT ? row : MT - 1;
        bf16x8 Af[4];
#pragma unroll
        for (int ks = 0; ks < 4; ++ks) Af[ks] = *(const bf16x8*)(a.qa + (size_t)rowc * 512 + h * 64 + ks * 16 + hi * 8);
#pragma unroll
        for (int nt = 0; nt < 4; ++nt) {
            f32x16 acc;
#pragma unroll
            for (int i = 0; i < 16; ++i) acc[i] = 0.f;
#pragma unroll
            for (int ks = 0; ks < 4; ++ks) { const bf16x8 Bf = *(const bf16x8*)(a.WukT + ((size_t)h * 128 + nt * 32 + r32) * 64 + ks * 16 + hi * 8); acc = __builtin_amdgcn_mfma_f32_32x32x16_bf16(Af[ks], Bf, acc, 0, 0, 0); }
#pragma unroll
            for (int i = 0; i < 16; ++i) { const int rr = rt * 32 + (i & 3) + 8 * (i >> 2) + 4 * hi; if (rr < MT) a.qlat[(size_t)rr * 1024 + h * 128 + nt * 32 + r32] = f2bf(acc[i] * 0.125f); }
        }
    }
}

namespace route {
constexpr int AP = 2064;
constexpr int L_AHI = 0, L_ALO = 32 * AP, L_PART = 0  , L_LOG = 2 * 32 * AP  , L_CNT = L_LOG + 8192, L_BASE = L_CNT + 256, L_ENT = L_BASE + 256, L_END = L_ENT + 96 * 8 * 4;
struct Args { const float* y1; const float* g; const float* bta; const bf16_t* WrHi; const bf16_t* WrLo; const float* rbias; bf16_t* hb1; int* cnt; int* list_tok; int* tok_e; int* tok_pos; float* tok_gate; };
__device__ __forceinline__ void group(LAS unsigned char* lds, const Args& a, const int row0, const int nvalid, const int gi) {
    const int tid = fresh_tid(), lane = tid & 63, w = tid >> 6, r32 = lane & 31, hi = lane >> 5;
    __syncthreads();
    for (int q = 0; q < 4; ++q) {
        const int tl = 4 * w + q, row = row0 + tl;
        f32x4 v[4];
        if (tl < nvalid) {
#pragma unroll
            for (int j = 0; j < 4; ++j) v[j] = *(const f32x4*)(a.y1 + (size_t)row * D + 256 * j + lane * 4);
            float s = 0.f;
#pragma unroll
            for (int j = 0; j < 4; ++j) s += (v[j][0] + v[j][1]) + (v[j][2] + v[j][3]);
            const float mu = wave_sum(s) * (1.f / D); float s2 = 0.f;
#pragma unroll
            for (int j = 0; j < 4; ++j) { v[j] = v[j] - mu; s2 += (v[j][0] * v[j][0] + v[j][1] * v[j][1]) + (v[j][2] * v[j][2] + v[j][3] * v[j][3]); }
            const float rstd = rsqrtf(wave_sum(s2) * (1.f / D) + EPS);
#pragma unroll
            for (int j = 0; j < 4; ++j) v[j] = v[j] * rstd * *(const f32x4*)(a.g + 256 * j + lane * 4) + *(const f32x4*)(a.bta + 256 * j + lane * 4);
        } else {
#pragma unroll
            for (int j = 0; j < 4; ++j) v[j] = (f32x4){0.f, 0.f, 0.f, 0.f};
        }
#pragma unroll
        for (int j = 0; j < 4; ++j) {
            u32x2 h2; h2.x = pk2(v[j][0], v[j][1]); h2.y = pk2(v[j][2], v[j][3]);
            const float r0 = v[j][0] - bf2f((bf16_t)(h2.x & 0xffff)), r1 = v[j][1] - bf2f((bf16_t)(h2.x >> 16)), r2 = v[j][2] - bf2f((bf16_t)(h2.y & 0xffff)), r3 = v[j][3] - bf2f((bf16_t)(h2.y >> 16));
            u32x2 l2; l2.x = pk2(r0, r1); l2.y = pk2(r2, r3);
            if (tl < nvalid) *(u32x2*)(a.hb1 + (size_t)row * D + 256 * j + lane * 4) = h2;
            *(LAS u32x2*)(lds + L_AHI + tl * AP + (256 * j + lane * 4) * 2) = h2; *(LAS u32x2*)(lds + L_ALO + tl * AP + (256 * j + lane * 4) * 2) = l2;
        }
    }
    __syncthreads();
    f32x16 acc[2];
#pragma unroll
    for (int nt = 0; nt < 2; ++nt)
#pragma unroll
        for (int i = 0; i < 16; ++i) acc[nt][i] = 0.f;
#pragma unroll
    for (int ks = 0; ks < 8; ++ks) {
        const int k0 = 128 * w + 16 * ks + 8 * hi;
        const bf16x8 Ah = *(const LAS bf16x8*)(lds + L_AHI + r32 * AP + k0 * 2), Al = *(const LAS bf16x8*)(lds + L_ALO + r32 * AP + k0 * 2);
#pragma unroll
        for (int nt = 0; nt < 2; ++nt) {
            const bf16x8 Bh = *(const bf16x8*)(a.WrHi + (size_t)(nt * 32 + r32) * D + k0), Bl = *(const bf16x8*)(a.WrLo + (size_t)(nt * 32 + r32) * D + k0);
            acc[nt] = __builtin_amdgcn_mfma_f32_32x32x16_bf16(Ah, Bh, acc[nt], 0, 0, 0);
            acc[nt] = __builtin_amdgcn_mfma_f32_32x32x16_bf16(Al, Bh, acc[nt], 0, 0, 0);
            acc[nt] = __builtin_amdgcn_mfma_f32_32x32x16_bf16(Ah, Bl, acc[nt], 0, 0, 0);
        }
    }
    __syncthreads();
#pragma unroll
    for (int nt = 0; nt < 2; ++nt)
#pragma unroll
        for (int i = 0; i < 16; ++i) { const int tk = (i & 3) + 8 * (i >> 2) + 4 * hi; *(LAS float*)(lds + L_PART + w * 8192 + (tk * 64 + nt * 32 + r32) * 4) = acc[nt][i]; }
    __syncthreads();
    { f32x4 s = *(const LAS f32x4*)(lds + L_PART + tid * 16);
#pragma unroll
      for (int ww = 1; ww < 8; ++ww) s += *(const LAS f32x4*)(lds + L_PART + ww * 8192 + tid * 16);
      *(LAS f32x4*)(lds + L_LOG + tid * 16) = s; }
    __syncthreads();
    for (int q = 0; q < 4; ++q) {
        const int tl = 4 * w + q, row = row0 + tl; if (tl >= nvalid) break;
        const float lg = *(const LAS float*)(lds + L_LOG + (tl * 64 + lane) * 4);
        const float score = 1.f / (1.f + expf(-lg)), sel = score + a.rbias[lane];
        const int gidx = lane >> 3;
        float m1 = sel; m1 = fmaxf(m1, __shfl_xor(m1, 1)); m1 = fmaxf(m1, __shfl_xor(m1, 2)); m1 = fmaxf(m1, __shfl_xor(m1, 4));
        const unsigned long long eq = __ballot(sel == m1); const unsigned gb = (unsigned)(eq >> (8 * gidx)) & 0xffu; const int first = __ffs(gb) - 1;
        float m2 = ((lane & 7) == first) ? -INFINITY : sel; m2 = fmaxf(m2, __shfl_xor(m2, 1)); m2 = fmaxf(m2, __shfl_xor(m2, 2)); m2 = fmaxf(m2, __shfl_xor(m2, 4));
        const float gs = m1 + m2;
        int grank = 0;
#pragma unroll
        for (int g2 = 0; g2 < 8; ++g2) { const float gv = __shfl(gs, 8 * g2); grank += (gv > gs || (gv == gs && g2 < gidx)) ? 1 : 0; }
        const float selv = grank < 4 ? sel : -INFINITY;
        int erank = 0;
        for (int e2 = 0; e2 < 64; ++e2) { const float ev = __shfl(selv, e2); erank += (ev > selv || (ev == selv && e2 < lane)) ? 1 : 0; }
        const bool take = grank < 4 && erank < 8;
        const float ssum = wave_sum(take ? score : 0.f);
        if (take) {
            const int lr = __hip_atomic_fetch_add((LAS int*)(lds + L_CNT) + lane, 1, __ATOMIC_RELAXED, __HIP_MEMORY_SCOPE_WORKGROUP);
            a.tok_e[row * 8 + erank] = lane; a.tok_gate[row * 8 + erank] = score / ssum * 2.5f;
            *(LAS unsigned*)(lds + L_ENT + ((gi * 32 + tl) * 8 + erank) * 4) = (unsigned)lane | ((unsigned)lr << 8);
        }
    }
}
__device__ __forceinline__ void phase(LAS unsigned char* lds, const Args& a) {
    const int tid = fresh_tid();
    for (int c = fresh_bid(); c < 256; c += gridDim.x) {
        __syncthreads();
        if (tid < 64) ((LAS int*)(lds + L_CNT))[tid] = 0;
        const int ng = c == 0 ? 3 : 2;
#pragma unroll 1
        for (int gi = 0; gi < ng; ++gi) group(lds, a, gi < 2 ? 64 * c + 32 * gi : MR, gi < 2 ? 32 : NMETA, gi);
        __syncthreads();
        if (tid < 64) ((LAS int*)(lds + L_BASE))[tid] = atomicAdd(a.cnt + tid, ((LAS int*)(lds + L_CNT))[tid]);
        __syncthreads();
        for (int i = tid; i < ng * 32 * 8; i += 512) {
            const int gi = i >> 8, tl = (i >> 3) & 31, slot = i & 7; if (gi == 2 && tl >= NMETA) continue;
            const int row = gi < 2 ? 64 * c + 32 * gi + tl : MR + tl;
            const unsigned en = *(const LAS unsigned*)(lds + L_ENT + i * 4); const int e = en & 0xff, pos = ((const LAS int*)(lds + L_BASE))[e] + (int)(en >> 8);
            a.tok_pos[row * 8 + slot] = pos; a.list_tok[(size_t)e * LSTRIDE + pos] = row;
        }
    }
    __syncthreads();
}
}

struct CombArgs { const bf16_t* hb1; const bf16_t* yrows; const int* cnt; const int* tok_e; const int* tok_pos; const float* tok_gate; const float* g; const float* bta; bf16_t* hb; float* out; };
__device__ __forceinline__ void phase_combine(LAS unsigned char* lds, const CombArgs& a) {
    moe_tile_prefix(lds, a.cnt);
    LAS const int* tf = (LAS const int*)(lds + L_TF);
    const int tid = fresh_tid(), lane = tid & 63, w = tid >> 6, gw = fresh_bid() * 8 + w, ngw = gridDim.x * 8;
    for (int row = gw; row < MT; row += ngw) {
        const int4 e0 = *(const int4*)(a.tok_e + row * 8), e1 = *(const int4*)(a.tok_e + row * 8 + 4), p0 = *(const int4*)(a.tok_pos + row * 8), p1 = *(const int4*)(a.tok_pos + row * 8 + 4);
        const f32x4 g0v = *(const f32x4*)(a.tok_gate + row * 8), g1v = *(const f32x4*)(a.tok_gate + row * 8 + 4);
        size_t rr[9]; float gt[9];
        rr[0] = (size_t)tf[e0.x] * 256 + p0.x; rr[1] = (size_t)tf[e0.y] * 256 + p0.y; rr[2] = (size_t)tf[e0.z] * 256 + p0.z; rr[3] = (size_t)tf[e0.w] * 256 + p0.w;
        rr[4] = (size_t)tf[e1.x] * 256 + p1.x; rr[5] = (size_t)tf[e1.y] * 256 + p1.y; rr[6] = (size_t)tf[e1.z] * 256 + p1.z; rr[7] = (size_t)tf[e1.w] * 256 + p1.w; rr[8] = (size_t)tf[64] * 256 + row;
        gt[0] = g0v[0]; gt[1] = g0v[1]; gt[2] = g0v[2]; gt[3] = g0v[3]; gt[4] = g1v[0]; gt[5] = g1v[1]; gt[6] = g1v[2]; gt[7] = g1v[3]; gt[8] = 1.f;
        u32x4 ld[10][2];
        ld[9][0] = *(const u32x4*)(a.hb1 + (size_t)row * D + lane * 8); ld[9][1] = *(const u32x4*)(a.hb1 + (size_t)row * D + 512 + lane * 8);
#pragma unroll
        for (int k = 0; k < 9; ++k) { ld[k][0] = *(const u32x4*)(a.yrows + rr[k] * D + lane * 8); ld[k][1] = *(const u32x4*)(a.yrows + rr[k] * D + 512 + lane * 8); }
        float y[16];
        { float t[8]; unpack8(ld[9][0], t);
#pragma unroll
          for (int i = 0; i < 8; ++i) y[i] = t[i] * DN_ALPHA;
          unpack8(ld[9][1], t);
#pragma unroll
          for (int i = 0; i < 8; ++i) y[8 + i] = t[i] * DN_ALPHA; }
#pragma unroll
        for (int k = 0; k < 9; ++k) {
            float t[8]; unpack8(ld[k][0], t);
#pragma unroll
            for (int i = 0; i < 8; ++i) y[i] += gt[k] * t[i];
            unpack8(ld[k][1], t);
#pragma unroll
            for (int i = 0; i < 8; ++i) y[8 + i] += gt[k] * t[i];
        }
        float s = 0.f;
#pragma unroll
        for (int i = 0; i < 16; ++i) s += y[i];
        const float mu = wave_sum(s) * (1.f / D); float s2 = 0.f;
#pragma unroll
        for (int i = 0; i < 16; ++i) { y[i] -= mu; s2 += y[i] * y[i]; }
        const float rstd = rsqrtf(wave_sum(s2) * (1.f / D) + EPS);
#pragma unroll
        for (int hlf = 0; hlf < 2; ++hlf) {
            const int c0 = 512 * hlf + lane * 8;
            const f32x4 g0 = *(const f32x4*)(a.g + c0), g1 = *(const f32x4*)(a.g + c0 + 4), b0 = *(const f32x4*)(a.bta + c0), b1 = *(const f32x4*)(a.bta + c0 + 4);
            f32x4 o0, o1;
#pragma unroll
            for (int i = 0; i < 4; ++i) { o0[i] = y[8 * hlf + i] * rstd * g0[i] + b0[i]; o1[i] = y[8 * hlf + 4 + i] * rstd * g1[i] + b1[i]; }
            *(u32x4*)(a.hb + (size_t)row * D + c0) = pk8(o0, o1);
            if (a.out && row < MR) { *(f32x4*)(a.out + (size_t)row * D + c0) = o0; *(f32x4*)(a.out + (size_t)row * D + c0 + 4) = o1; }
        }
    }
}
struct TrJob { const float* W; bf16_t* Wt; size_t w_zstride, wt_zstride; int K, N, ldwt, G, gstride, row_off, nz, pad; };
__device__ __forceinline__ int tr_items(const TrJob& j) { return (j.K / 64) * (j.N / 32) * j.nz; }
__device__ __forceinline__ void tr_item(LAS float* scr, const TrJob& j, int item, int lane) {
    const int nb = j.N / 32, kb = j.K / 64, per = nb * kb, z = item / per, r = item % per, k0 = (r / nb) * 64, n0 = (r % nb) * 32;
    const float* W = j.W + (size_t)z * j.w_zstride; bf16_t* Wt = j.Wt + (size_t)z * j.wt_zstride;
#pragma unroll 8
    for (int i = 0; i < 32; ++i) { const int kk = 2 * i + (lane >> 5); scr[kk * 33 + (lane & 31)] = W[(size_t)(k0 + kk) * j.N + n0 + (lane & 31)]; }
    asm volatile("s_waitcnt lgkmcnt(0)" ::: "memory");
    const int c = lane & 7;
#pragma unroll
    for (int q = 0; q < 4; ++q) { const int n = (lane >> 3) + 8 * q; const LAS float* s = scr + (8 * c) * 33 + n;
        u32x4 o; o.x = pk2(s[0 * 33], s[1 * 33]); o.y = pk2(s[2 * 33], s[3 * 33]); o.z = pk2(s[4 * 33], s[5 * 33]); o.w = pk2(s[6 * 33], s[7 * 33]);
        const int nn = n0 + n, dn = (nn / j.G) * j.gstride + (nn % j.G) + j.row_off;
        *(u32x4*)(Wt + (size_t)dn * j.ldwt + k0 + 8 * c) = o; }
    asm volatile("s_waitcnt lgkmcnt(0)" ::: "memory");
}
__device__ __forceinline__ TrJob mk_job(const float* W, bf16_t* Wt, int K, int N, size_t wz, size_t wtz, int ldwt, int G, int gstride, int row_off, int nz) {
    TrJob j; j.W = W; j.Wt = Wt; j.w_zstride = wz; j.wt_zstride = wtz; j.K = K; j.N = N; j.ldwt = ldwt; j.G = G; j.gstride = gstride; j.row_off = row_off; j.nz = nz; j.pad = 0; return j;
}
struct ProArgs { const float* x; const float* meta; const float* w_in; const float* w_uk; const float* w_uv; const float* w_o; const float* w_router; const float* w_gate; const float* w_up; const float* w_down;
                 const float* ws_gate; const float* ws_up; const float* ws_down; bf16_t* hb; f32x2* rot; bf16_t* WinT; bf16_t* WoT; bf16_t* WukT; bf16_t* WuvT; bf16_t* WrHi; bf16_t* WrLo; bf16_t* W1T; bf16_t* W2T; int* ctl; };
__device__ __forceinline__ void phase_prologue(LAS unsigned char* lds, const ProArgs& a) {
    const int tid = fresh_tid(), lane = tid & 63, w = tid >> 6, bid = fresh_bid(), gw = bid * 8 + w, ngw = gridDim.x * 8;
    const size_t gt = (size_t)bid * 512 + tid, ngt = (size_t)gridDim.x * 512;
    if (bid == 0) for (int i = tid; i < 4096; i += 512) a.ctl[i] = 0;
    for (size_t i = gt; i < (size_t)MP * D / 8; i += ngt) { const size_t e = i * 8; const int row = (int)(e / D), col = (int)(e % D);
        f32x4 v0 = (f32x4){0.f, 0.f, 0.f, 0.f}, v1 = v0;
        if (row < MR) { v0 = *(const f32x4*)(a.x + e); v1 = *(const f32x4*)(a.x + e + 4); } else if (row < MT) { v0 = *(const f32x4*)(a.meta + (size_t)(row - MR) * D + col); v1 = *(const f32x4*)(a.meta + (size_t)(row - MR) * D + col + 4); }
        *(u32x4*)(a.hb + e) = pk8(v0, v1); }
    for (size_t i = gt; i < (size_t)T * 32; i += ngt) { const int p = (int)(i >> 5), j = (int)(i & 31); const float inv = exp2f(-(float)j * (13.287712379549449f / 32.f)); float sn, cs; sincosf((float)p * inv, &sn, &cs); a.rot[i] = (f32x2){cs, sn}; }
    for (size_t i = gt; i < (size_t)NL * 64 * D; i += ngt) { const int l = (int)(i / (64 * D)), r = (int)(i % (64 * D)), e = r / D, k = r % D; const float v = a.w_router[((size_t)l * D + k) * 64 + e];
        const bf16_t h = f2bf(v); a.WrHi[i] = h; a.WrLo[i] = f2bf(v - bf2f(h)); }
    LAS float* scr = (LAS float*)lds + w * (64 * 33);
    for (int it = gw; it < NL * (DINP / 32) * (D / 64); it += ngw) {
        const int l = it / ((DINP / 32) * (D / 64)), r = it % ((DINP / 32) * (D / 64)), n0 = (r % (DINP / 32)) * 32, k0 = (r / (DINP / 32)) * 64;
        const int sc = win_src_col(n0 + (lane & 31)); const float* W = a.w_in + (size_t)l * D * DIN;
#pragma unroll 8
        for (int i = 0; i < 32; ++i) { const int kk = 2 * i + (lane >> 5); scr[kk * 33 + (lane & 31)] = sc >= 0 ? W[(size_t)(k0 + kk) * DIN + sc] : 0.f; }
        asm volatile("s_waitcnt lgkmcnt(0)" ::: "memory");
        const int c = lane & 7;
#pragma unroll
        for (int q = 0; q < 4; ++q) { const int n = (lane >> 3) + 8 * q; const LAS float* s = scr + (8 * c) * 33 + n;
            u32x4 o; o.x = pk2(s[0 * 33], s[1 * 33]); o.y = pk2(s[2 * 33], s[3 * 33]); o.z = pk2(s[4 * 33], s[5 * 33]); o.w = pk2(s[6 * 33], s[7 * 33]);
            *(u32x4*)(a.WinT + ((size_t)l * DINP + n0 + n) * D + k0 + 8 * c) = o; }
        asm volatile("s_waitcnt lgkmcnt(0)" ::: "memory");
    }
#define RUN_JOB(J) do { const TrJob _j = (J); const int _n = tr_items(_j); for (int it = gw; it < _n; it += ngw) tr_item(scr, _j, it, lane); } while (0)
    RUN_JOB(mk_job(a.w_o, a.WoT, D, D, (size_t)D * D, (size_t)D * D, D, D, 0, 0, NL));
    RUN_JOB(mk_job(a.w_uk, a.WukT, 64, 128, 64 * 128, 128 * 64, 64, 128, 0, 0, NL * 8));
    RUN_JOB(mk_job(a.w_uv, a.WuvT, 128, 64, 128 * 64, 64 * 128, 128, 64, 0, 0, NL * 8));
    for (int l = 0; l < NL; ++l) {
        bf16_t* W1 = a.W1T + (size_t)l * 65 * 512 * D; bf16_t* W2 = a.W2T + (size_t)l * 65 * D * DE;
        RUN_JOB(mk_job(a.w_gate + (size_t)l * NE * D * DE, W1, D, DE, (size_t)D * DE, (size_t)512 * D, D, 128, 256, 0, NE));
        RUN_JOB(mk_job(a.w_up + (size_t)l * NE * D * DE, W1, D, DE, (size_t)D * DE, (size_t)512 * D, D, 128, 256, 128, NE));
        RUN_JOB(mk_job(a.ws_gate + (size_t)l * D * DE, W1 + (size_t)NE * 512 * D, D, DE, 0, 0, D, 128, 256, 0, 1));
        RUN_JOB(mk_job(a.ws_up + (size_t)l * D * DE, W1 + (size_t)NE * 512 * D, D, DE, 0, 0, D, 128, 256, 128, 1));
        RUN_JOB(mk_job(a.w_down + (size_t)l * NE * DE * D, W2, DE, D, (size_t)DE * D, (size_t)D * DE, DE, D, 0, 0, NE));
        RUN_JOB(mk_job(a.ws_down + (size_t)l * DE * D, W2 + (size_t)NE * D * DE, DE, D, 0, 0, DE, D, 0, 0, 1));
    }
#undef RUN_JOB
}
namespace attn {
constexpr int NT_MAX = 65, NCH = 9;
constexpr int KI_PITCH = 144;
constexpr int L_KI = 0, L_GATH = 0, L_OLDS = 65536, OL_PITCH = 2064, L_LIST = L_OLDS + 32 * OL_PITCH  , L_WQ = L_LIST + 8 * 4 * 256 * 2  , L_END = L_WQ + 1024;
typedef short v4i16_t __attribute__((ext_vector_type(4)));
__device__ __forceinline__ unsigned off_b(unsigned row, unsigned ch) { return 256u * row + 16u * (ch ^ (((row & 3) << 2) | ((row >> 2) & 3))); }
__device__ __forceinline__ unsigned fkey20(float f, int kidx) { unsigned u = __float_as_uint(f); u = (u & 0x80000000u) ? ~u : (u | 0x80000000u); return (u & 0xFFFFF000u) | (unsigned)(4095 - kidx); }

struct Args { const bf16_t* qi; const float* wi; const bf16_t* ki; const bf16_t* qlat; const bf16_t* ckv; const bf16_t* WuvT; bf16_t* mix; };

__device__ __forceinline__ void unit(LAS unsigned char* lds, const Args& a, const int b, const int row0, const int p0, const int nq) {
    int tid = threadIdx.x; asm volatile("" : "+v"(tid));
    const int lane = tid & 63, w = __builtin_amdgcn_readfirstlane(tid >> 6), r32 = lane & 31, hi = lane >> 5;
    const int nk = p0 + nq, ntile = (nk + 31) >> 5;
    const size_t kvb = (size_t)b * T;
    unsigned u[NT_MAX][2];
#pragma unroll
    for (int kt = 0; kt < NT_MAX; ++kt) { u[kt][0] = 0u; u[kt][1] = 0u; }
    {
        const int qa_ = 4 * w + (r32 >> 3); const int qrow = row0 + (qa_ < nq ? qa_ : 0);
        bf16x8 Af[4];
#pragma unroll
        for (int ks = 0; ks < 4; ++ks) Af[ks] = *(const bf16x8*)(a.qi + (size_t)qrow * 512 + (r32 & 7) * 64 + ks * 16 + hi * 8);
        LAS float* wql = (LAS float*)(lds + L_WQ) + w * 32;
        if (lane < 32) { const int q = lane >> 3, hd = lane & 7, ql = 4 * w + q; wql[(hd >> 2) * 16 + q * 4 + (hd & 3)] = a.wi[(size_t)(row0 + (ql < nq ? ql : 0)) * 8 + hd]; }
        const int pq0 = p0 + 4 * w + 2 * hi, pq1 = pq0 + 1;
        const bool v0 = 4 * w + 2 * hi < nq, v1 = 4 * w + 2 * hi + 1 < nq;
        const unsigned char* kst = (const unsigned char*)(a.ki + kvb * 64) + (size_t)(tid >> 3) * 128 + (tid & 7) * 16;
        unsigned koff = 0;
        const unsigned lst = L_KI + (tid >> 3) * KI_PITCH + (tid & 7) * 16;
#pragma unroll
        for (int c = 0; c < NCH; ++c) {
            if (c * 8 < ntile) {
                __syncthreads();
#pragma unroll
                for (int j = 0; j < 4; ++j) *(LAS u32x4*)(lds + lst + j * 64 * KI_PITCH) = *(const u32x4*)(kst + koff + j * 8192);
                koff += 32768; asm volatile("" : "+v"(koff));
                __syncthreads();
#pragma unroll
                for (int j = 0; j < 8; ++j) {
                    const int kt = c * 8 + j;
                    if (kt < NT_MAX && kt < ntile) {
                        f32x16 acc;
#pragma unroll
                        for (int i = 0; i < 16; ++i) acc[i] = 0.f;
#pragma unroll
                        for (int ks = 0; ks < 4; ++ks) { const bf16x8 Bf = *(const LAS bf16x8*)(lds + L_KI + (j * 32 + r32) * KI_PITCH + ks * 32 + hi * 16); acc = __builtin_amdgcn_mfma_f32_32x32x16_bf16(Af[ks], Bf, acc, 0, 0, 0); }
                        float part[4];
#pragma unroll
                        for (int q = 0; q < 4; ++q) { const f32x4 wv = *(const LAS f32x4*)(wql + hi * 16 + q * 4);
                            part[q] = (wv[0] * fmaxf(acc[4 * q], 0.f) + wv[1] * fmaxf(acc[4 * q + 1], 0.f)) + (wv[2] * fmaxf(acc[4 * q + 2], 0.f) + wv[3] * fmaxf(acc[4 * q + 3], 0.f)); }
                        const float s0 = (hi ? part[2] : part[0]) + __shfl_xor(hi ? part[0] : part[2], 32);
                        const float s1 = (hi ? part[3] : part[1]) + __shfl_xor(hi ? part[1] : part[3], 32);
                        const int kidx = kt * 32 + r32;
                        u[kt][0] = (v0 && kidx <= pq0) ? fkey20(s0, kidx) : 0u;
                        u[kt][1] = (v1 && kidx <= pq1) ? fkey20(s1, kidx) : 0u;
                    }
                }
            }
        }
        __syncthreads();
        unsigned T0 = 1u, T1 = 1u;
        const bool need0 = v0 && pq0 + 1 > NSEL, need1 = v1 && pq1 + 1 > NSEL;
        if (__ballot(need0 || need1)) {
            unsigned pre0 = 0u, pre1 = 0u; bool d0 = !need0, d1 = !need1;
#pragma unroll 1
            for (int bit = 31; bit >= 0; --bit) {
                const unsigned c0 = pre0 | (1u << bit), c1 = pre1 | (1u << bit); int n0 = 0, n1 = 0;
#pragma unroll
                for (int c = 0; c < NCH; ++c) if (c * 8 < ntile) {
#pragma unroll
                    for (int j = 0; j < 8; ++j) if (c * 8 + j < NT_MAX) { n0 += (u[c * 8 + j][0] >= c0) ? 1 : 0; n1 += (u[c * 8 + j][1] >= c1) ? 1 : 0; } }
#pragma unroll
                for (int o = 1; o < 32; o <<= 1) { n0 += __shfl_xor(n0, o); n1 += __shfl_xor(n1, o); }
                if (!d0) { if (n0 >= NSEL) pre0 = c0; if (n0 == NSEL) { T0 = c0; d0 = true; } }
                if (!d1) { if (n1 >= NSEL) pre1 = c1; if (n1 == NSEL) { T1 = c1; d1 = true; } }
                if (!__ballot(!d0 || !d1)) break;
            }
            if (!d0) T0 = pre0; if (!d1) T1 = pre1;
        }
        LAS unsigned short* li0 = (LAS unsigned short*)(lds + L_LIST) + (w * 4 + 2 * hi) * 256; LAS unsigned short* li1 = li0 + 256;
        int base0 = 0, base1 = 0;
#pragma unroll
        for (int c = 0; c < NCH; ++c) if (c * 8 < ntile) {
#pragma unroll
            for (int j = 0; j < 8; ++j) if (c * 8 + j < NT_MAX) { const int kt = c * 8 + j;
                { const bool f = u[kt][0] >= T0; const unsigned long long m = __ballot(f); const unsigned mm = hi ? (unsigned)(m >> 32) : (unsigned)m; const int pre = __popc(mm & ((1u << r32) - 1u));
                  if (f) li0[base0 + pre] = (unsigned short)(kt * 32 + r32); base0 += __popc(mm); }
                { const bool f = u[kt][1] >= T1; const unsigned long long m = __ballot(f); const unsigned mm = hi ? (unsigned)(m >> 32) : (unsigned)m; const int pre = __popc(mm & ((1u << r32) - 1u));
                  if (f) li1[base1 + pre] = (unsigned short)(kt * 32 + r32); base1 += __popc(mm); } }
        }
    }
    asm volatile("s_waitcnt lgkmcnt(0)" ::: "memory");
    int lane4 = lane; asm volatile("" : "+v"(lane4));
    const int nn = lane4 & 15, g = lane4 >> 4;
    LAS unsigned char* gb = lds + L_GATH + w * 8192;
#pragma unroll 1
    for (int q = 0; q < 4; ++q) {
        const int ql = 4 * w + q; if (ql >= nq) break;
        const int row = row0 + ql, pq = p0 + ql, nsel = pq + 1 < NSEL ? pq + 1 : NSEL, nch = (nsel + 31) >> 5;
        const LAS unsigned short* li = (const LAS unsigned short*)(lds + L_LIST) + (w * 4 + q) * 256;
        bf16x8 Bq[4];
#pragma unroll
        for (int ks = 0; ks < 4; ++ks) { if (nn < 8) Bq[ks] = *(const bf16x8*)(a.qlat + (size_t)row * 1024 + nn * 128 + ks * 32 + g * 8); else Bq[ks] = (bf16x8){0, 0, 0, 0, 0, 0, 0, 0}; }
        f32x4 o[8];
#pragma unroll
        for (int ct = 0; ct < 8; ++ct) o[ct] = (f32x4){0.f, 0.f, 0.f, 0.f};
        float mrun = -INFINITY, lrun = 0.f;
        const int gk = lane4 >> 1, gh = lane4 & 1;
        u32x4 pre[8];
        { const int slot = gk < nsel ? gk : 0; const size_t src = (kvb + li[slot]) * 128 + gh * 64;
#pragma unroll
          for (int jj = 0; jj < 8; ++jj) pre[jj] = *(const u32x4*)(a.ckv + src + jj * 8); }
#pragma unroll 1
        for (int c = 0; c < nch; ++c) {
#pragma unroll
            for (int jj = 0; jj < 8; ++jj) *(LAS u32x4*)(gb + off_b(gk, gh * 8 + jj)) = pre[jj];
            if (c + 1 < nch) { const int s_ = (c + 1) * 32 + gk; const int slot = s_ < nsel ? s_ : 0; const size_t src = (kvb + li[slot]) * 128 + gh * 64;
#pragma unroll
              for (int jj = 0; jj < 8; ++jj) pre[jj] = *(const u32x4*)(a.ckv + src + jj * 8); }
            asm volatile("" ::: "memory");
            f32x4 s[2];
#pragma unroll
            for (int t2 = 0; t2 < 2; ++t2) { s[t2] = (f32x4){0.f, 0.f, 0.f, 0.f}; const unsigned krow = 8 * (nn >> 2) + (nn & 3) + 4 * t2;
#pragma unroll
                for (int ks = 0; ks < 4; ++ks) { const bf16x8 Ak = *(const LAS bf16x8*)(gb + off_b(krow, 4 * ks + g)); s[t2] = __builtin_amdgcn_mfma_f32_16x16x32_bf16(Ak, Bq[ks], s[t2], 0, 0, 0); } }
            float mx = -INFINITY;
#pragma unroll
            for (int t2 = 0; t2 < 2; ++t2)
#pragma unroll
                for (int r = 0; r < 4; ++r) { const int slot = c * 32 + 8 * g + r + 4 * t2; if (slot >= nsel) s[t2][r] = -INFINITY; mx = fmaxf(mx, s[t2][r]); }
            mx = fmaxf(mx, __shfl_xor(mx, 16)); mx = fmaxf(mx, __shfl_xor(mx, 32));
            const float mnew = fmaxf(mrun, mx), alpha = __expf(mrun - mnew);
            float ps = 0.f; f32x4 p0v, p1v;
#pragma unroll
            for (int r = 0; r < 4; ++r) { p0v[r] = __expf(s[0][r] - mnew); p1v[r] = __expf(s[1][r] - mnew); ps += p0v[r] + p1v[r]; }
            lrun = lrun * alpha + ps; mrun = mnew;
            const u32x4 pw = pk8(p0v, p1v); const bf16x8 Pb = __builtin_bit_cast(bf16x8, pw);
#pragma unroll
            for (int ct = 0; ct < 8; ++ct) {
                const unsigned qq = (lane4 & 15) >> 2, pp = lane4 & 3;
                const v4i16_t lo = __builtin_amdgcn_ds_read_tr16_b64_v4i16((LAS v4i16_t*)(gb + off_b(8 * g + qq, 2 * ct + (pp >> 1)) + 8 * (pp & 1)));
                const v4i16_t hi4 = __builtin_amdgcn_ds_read_tr16_b64_v4i16((LAS v4i16_t*)(gb + off_b(8 * g + 4 + qq, 2 * ct + (pp >> 1)) + 8 * (pp & 1)));
                const bf16x8 Ak = (bf16x8){lo[0], lo[1], lo[2], lo[3], hi4[0], hi4[1], hi4[2], hi4[3]};
                o[ct] = o[ct] * alpha;
                o[ct] = __builtin_amdgcn_mfma_f32_16x16x32_bf16(Ak, Pb, o[ct], 0, 0, 0);
            }
            asm volatile("" ::: "memory");
        }
        lrun += __shfl_xor(lrun, 16); lrun += __shfl_xor(lrun, 32);
        const float il = 1.f / lrun;
        if (nn < 8) {
#pragma unroll
            for (int ct = 0; ct < 8; ++ct) { u32x2 wv; wv.x = pk2(o[ct][0] * il, o[ct][1] * il); wv.y = pk2(o[ct][2] * il, o[ct][3] * il);
                *(LAS u32x2*)(lds + L_OLDS + ql * OL_PITCH + nn * 256 + (16 * ct + 4 * g) * 2) = wv; }
        }
    }
    __syncthreads();
    {
        int lane5 = lane; asm volatile("" : "+v"(lane5));
        const int r32 = lane5 & 31, hi = lane5 >> 5;
        f32x16 oa[2];
#pragma unroll
        for (int nt = 0; nt < 2; ++nt)
#pragma unroll
            for (int i = 0; i < 16; ++i) oa[nt][i] = 0.f;
        const bf16_t* wv = a.WuvT + (size_t)w * 64 * 128;
#pragma unroll
        for (int ks = 0; ks < 8; ++ks) {
            const bf16x8 Af = *(const LAS bf16x8*)(lds + L_OLDS + r32 * OL_PITCH + w * 256 + (ks * 16 + hi * 8) * 2);
#pragma unroll
            for (int nt = 0; nt < 2; ++nt) { const bf16x8 Bf = *(const bf16x8*)(wv + (size_t)(nt * 32 + r32) * 128 + ks * 16 + hi * 8); oa[nt] = __builtin_amdgcn_mfma_f32_32x32x16_bf16(Af, Bf, oa[nt], 0, 0, 0); }
        }
#pragma unroll
        for (int nt = 0; nt < 2; ++nt)
#pragma unroll
            for (int i = 0; i < 16; ++i) { const int ql = (i & 3) + 8 * (i >> 2) + 4 * hi; if (ql < nq) a.mix[(size_t)(row0 + ql) * 1024 + w * 64 + nt * 32 + r32] = f2bf(oa[nt][i]); }
    }
    __syncthreads();
}
__device__ __forceinline__ void phase(LAS unsigned char* lds, const Args& a) {
#pragma unroll 1
    for (int c = fresh_bid(); c < 256; c += gridDim.x) {
        const int bb = c >> 5, qt = c & 31, nu = c == 0 ? 3 : 2;
#pragma unroll 1
        for (int i = 0; i < nu; ++i) {
            const int qq = i == 0 ? 63 - qt : qt;
            const int b_ = i < 2 ? bb : 0, row0_ = i < 2 ? bb * SEQ + 32 * qq : MR, p0_ = i < 2 ? NMETA + 32 * qq : 0, nq_ = i < 2 ? 32 : NMETA;
            unit(lds, a, b_, row0_, p0_, nq_);
        }
    }
}
}
namespace ret {
constexpr int NCHK = 17, RP = 144;
constexpr int L_V = 0, L_K = 32768, L_S = L_K + 128 * 256, L_PART = L_S + 128 * RP, L_END = L_PART + 2048;
typedef short v4i16_t __attribute__((ext_vector_type(4)));
__device__ __forceinline__ unsigned off_b(unsigned row, unsigned ch) { return 256u * row + 16u * (ch ^ (((row & 3) << 2) | ((row >> 2) & 3))); }
__device__ __forceinline__ v4i16_t trr(LAS unsigned char* p) { return __builtin_amdgcn_ds_read_tr16_b64_v4i16((LAS v4i16_t*)p); }
struct Args { const bf16_t* qr; const bf16_t* kr; const bf16_t* vr; const bf16_t* sg; const float* rw; float* kvs; bf16_t* mix; };

template <bool KTR>
__device__ __forceinline__ void stage_kv(LAS unsigned char* lds, const Args& a, int b, int hh, int c, int tid) {
    const u32x4 z = (u32x4){0u, 0u, 0u, 0u};
#pragma unroll
    for (int j = 0; j < 4; ++j) { const int id = tid + 512 * j, row = id >> 4, ch = id & 15; const int p = c == 0 ? row - 112 : NMETA + 128 * (c - 1) + row;
        *(LAS u32x4*)(lds + L_V + off_b(row, ch)) = p >= 0 ? *(const u32x4*)(a.vr + ((size_t)b * T + p) * 512 + hh * 128 + ch * 8) : z; }
#pragma unroll
    for (int j = 0; j < 2; ++j) { const int id = tid + 512 * j, row = id >> 3, ch = id & 7; const int p = c == 0 ? row - 112 : NMETA + 128 * (c - 1) + row;
        const u32x4 v = p >= 0 ? *(const u32x4*)(a.kr + ((size_t)b * T + p) * 256 + hh * 64 + ch * 8) : z;
        if (KTR) *(LAS u32x4*)(lds + L_K + off_b(row, ch)) = v; else *(LAS u32x4*)(lds + L_K + row * RP + ch * 16) = v; }
}
__device__ __forceinline__ void r1_unit(LAS unsigned char* lds, const Args& a, int b, int hh, int c) {
    int tid = threadIdx.x; asm volatile("" : "+v"(tid));
    const int lane = tid & 63, w = __builtin_amdgcn_readfirstlane(tid >> 6), vt = w >> 1, dt = w & 1;
    __syncthreads();
    stage_kv<true>(lds, a, b, hh, c, tid);
    __syncthreads();
    const unsigned h = lane >> 5, blk = (lane >> 4) & 1, q = (lane & 15) >> 2, p = lane & 3;
    f32x16 acc;
#pragma unroll
    for (int i = 0; i < 16; ++i) acc[i] = 0.f;
#pragma unroll
    for (int ks = 0; ks < 8; ++ks) {
        const unsigned r0 = 16 * ks + 8 * h + q;
        const v4i16_t a0 = trr(lds + L_V + off_b(r0, 4 * vt + 2 * blk + (p >> 1)) + 8 * (p & 1)), a1 = trr(lds + L_V + off_b(r0 + 4, 4 * vt + 2 * blk + (p >> 1)) + 8 * (p & 1));
        const v4i16_t b0 = trr(lds + L_K + off_b(r0, 4 * dt + 2 * blk + (p >> 1)) + 8 * (p & 1)), b1 = trr(lds + L_K + off_b(r0 + 4, 4 * dt + 2 * blk + (p >> 1)) + 8 * (p & 1));
        const bf16x8 Af = (bf16x8){a0[0], a0[1], a0[2], a0[3], a1[0], a1[1], a1[2], a1[3]}, Bf = (bf16x8){b0[0], b0[1], b0[2], b0[3], b1[0], b1[1], b1[2], b1[3]};
        acc = __builtin_amdgcn_mfma_f32_32x32x16_bf16(Af, Bf, acc, 0, 0, 0);
    }
    const float g127 = exp2f(127.f * ret_log2_gamma(hh));
    float* dst = a.kvs + (((size_t)(b * 4 + hh) * NCHK + c) * 128) * 64;
#pragma unroll
    for (int i = 0; i < 16; ++i) { const int v = 32 * vt + (i & 3) + 8 * (i >> 2) + 4 * (int)h; dst[(size_t)v * 64 + 32 * dt + (lane & 31)] = acc[i] * g127; }
}
__device__ __forceinline__ void r2_unit(LAS unsigned char* lds, const Args& a, int b, int hh, int c) {
    int tid = threadIdx.x; asm volatile("" : "+v"(tid));
    const int lane = tid & 63, w = __builtin_amdgcn_readfirstlane(tid >> 6), qt = w & 3, vh = w >> 2, r32 = lane & 31, hi = lane >> 5;
    const float lg = ret_log2_gamma(hh);
    __syncthreads();
    stage_kv<false>(lds, a, b, hh, c, tid);
    { f32x4 s[4];
#pragma unroll
      for (int j = 0; j < 4; ++j) s[j] = (f32x4){0.f, 0.f, 0.f, 0.f};
      const float* src = a.kvs + ((size_t)(b * 4 + hh) * NCHK) * 8192 + tid * 4;
      for (int jc = 0; jc < c; ++jc) { const float wg = exp2f(lg * (float)(1 + 128 * (c - 1 - jc)));
#pragma unroll
          for (int j = 0; j < 4; ++j) s[j] += *(const f32x4*)(src + (size_t)jc * 8192 + j * 2048) * wg; }
#pragma unroll
      for (int j = 0; j < 4; ++j) { const int e = tid * 4 + j * 2048, v = e >> 6, d = e & 63; u32x2 wv; wv.x = pk2(s[j][0], s[j][1]); wv.y = pk2(s[j][2], s[j][3]); *(LAS u32x2*)(lds + L_S + v * RP + d * 2) = wv; } }
    const int nl_q = 32 * qt + r32; const int pq = c == 0 ? nl_q - 112 : NMETA + 128 * (c - 1) + nl_q;
    const bool qvalid = pq >= 0; const int qrow = c == 0 ? MR + (qvalid ? pq : 0) : b * SEQ + 128 * (c - 1) + nl_q;
    bf16x8 Bq[4];
#pragma unroll
    for (int ks = 0; ks < 4; ++ks) Bq[ks] = *(const bf16x8*)(a.qr + (size_t)qrow * 256 + hh * 64 + ks * 16 + hi * 8);
    __syncthreads();
    f32x16 oacc[2];
#pragma unroll
    for (int t = 0; t < 2; ++t) {
#pragma unroll
        for (int i = 0; i < 16; ++i) oacc[t][i] = 0.f;
#pragma unroll
        for (int ks = 0; ks < 4; ++ks) { const bf16x8 As = *(const LAS bf16x8*)(lds + L_S + (64 * vh + 32 * t + r32) * RP + ks * 32 + hi * 16); oacc[t] = __builtin_amdgcn_mfma_f32_32x32x16_bf16(As, Bq[ks], oacc[t], 0, 0, 0); }
    }
    const unsigned blk = (lane >> 4) & 1, q4 = (lane & 15) >> 2, p4 = lane & 3;
#pragma unroll 1
    for (int kt = 0; kt <= qt; ++kt) {
        f32x16 st;
#pragma unroll
        for (int i = 0; i < 16; ++i) st[i] = 0.f;
#pragma unroll
        for (int ks = 0; ks < 4; ++ks) { const bf16x8 Ak = *(const LAS bf16x8*)(lds + L_K + (32 * kt + r32) * RP + ks * 32 + hi * 16); st = __builtin_amdgcn_mfma_f32_32x32x16_bf16(Ak, Bq[ks], st, 0, 0, 0); }
        if (kt == qt) {
#pragma unroll
            for (int i = 0; i < 16; ++i) { const int kl = (i & 3) + 8 * (i >> 2) + 4 * hi; if (kl > r32) st[i] = 0.f; }
        }
#pragma unroll
        for (int s = 0; s < 2; ++s) {
            u32x4 pw; pw.x = pk2(st[8 * s], st[8 * s + 1]); pw.y = pk2(st[8 * s + 2], st[8 * s + 3]); pw.z = pk2(st[8 * s + 4], st[8 * s + 5]); pw.w = pk2(st[8 * s + 6], st[8 * s + 7]);
            const bf16x8 Bp = __builtin_bit_cast(bf16x8, pw);
#pragma unroll
            for (int t = 0; t < 2; ++t) {
                const unsigned r0 = 32 * kt + 16 * s + 4 * hi + q4, cch = 4 * (2 * vh + t) + 2 * blk + (p4 >> 1);
                const v4i16_t a0 = trr(lds + L_V + off_b(r0, cch) + 8 * (p4 & 1)), a1 = trr(lds + L_V + off_b(r0 + 8, cch) + 8 * (p4 & 1));
                const bf16x8 Av = (bf16x8){a0[0], a0[1], a0[2], a0[3], a1[0], a1[1], a1[2], a1[3]};
                oacc[t] = __builtin_amdgcn_mfma_f32_32x32x16_bf16(Av, Bp, oacc[t], 0, 0, 0);
            }
        }
    }
    float sm = 0.f, sq = 0.f;
#pragma unroll
    for (int t = 0; t < 2; ++t)
#pragma unroll
        for (int i = 0; i < 16; ++i) { sm += oacc[t][i]; sq += oacc[t][i] * oacc[t][i]; }
    sm += __shfl_xor(sm, 32); sq += __shfl_xor(sq, 32);
    LAS float* part = (LAS float*)(lds + L_PART);
    if (hi == 0) { part[(vh * 128 + nl_q) * 2] = sm; part[(vh * 128 + nl_q) * 2 + 1] = sq; }
    __syncthreads();
    const float tsm = part[nl_q * 2] + part[(128 + nl_q) * 2], tsq = part[nl_q * 2 + 1] + part[(128 + nl_q) * 2 + 1];
    const float mu = tsm * (1.f / 128.f), var = fmaxf(tsq * (1.f / 128.f) - mu * mu, 0.f), rstd = rsqrtf(var + EPS);
    if (qvalid && (c > 0 || b == 0)) {
#pragma unroll
        for (int t = 0; t < 2; ++t)
#pragma unroll
            for (int i4 = 0; i4 < 4; ++i4) {
                const int v = 64 * vh + 32 * t + 8 * i4 + 4 * hi;
                const f32x4 wv = *(const f32x4*)(a.rw + hh * 128 + v);
                const u32x2 gv = *(const u32x2*)(a.sg + (size_t)qrow * 512 + hh * 128 + v);
                const float g0 = bf2f((bf16_t)(gv.x & 0xffff)), g1 = bf2f((bf16_t)(gv.x >> 16)), g2 = bf2f((bf16_t)(gv.y & 0xffff)), g3 = bf2f((bf16_t)(gv.y >> 16));
                u32x2 ov; ov.x = pk2(g0 * ((oacc[t][4 * i4] - mu) * rstd * wv[0]), g1 * ((oacc[t][4 * i4 + 1] - mu) * rstd * wv[1]));
                ov.y = pk2(g2 * ((oacc[t][4 * i4 + 2] - mu) * rstd * wv[2]), g3 * ((oacc[t][4 * i4 + 3] - mu) * rstd * wv[3]));
                *(u32x2*)(a.mix + (size_t)qrow * 1024 + 512 + hh * 128 + v) = ov;
            }
    }
}
__device__ __forceinline__ void phase_r1(LAS unsigned char* lds, const Args& a) {
#pragma unroll 1
    for (int u = fresh_bid(); u < BATCH * 4 * 16; u += gridDim.x) r1_unit(lds, a, u >> 6, (u >> 4) & 3, u & 15);
    __syncthreads();
}
__device__ __forceinline__ void phase_r2(LAS unsigned char* lds, const Args& a) {
#pragma unroll 1
    for (int u = fresh_bid(); u < BATCH * 4 * 16 + 4; u += gridDim.x) { const bool m = u >= BATCH * 4 * 16; r2_unit(lds, a, m ? 0 : u >> 6, m ? u - BATCH * 4 * 16 : (u >> 4) & 3, m ? 0 : (u & 15) + 1); }
    __syncthreads();
}
}
constexpr size_t al256(size_t x) { return (x + 255) & ~(size_t)255; }
constexpr int LDS_BYTES = 160768;
struct WsMap { size_t bar, ctl, rot, WinT, WoT, WukT, WuvT, WrHi, WrLo, W1T, W2T, hb, U, qa, qi, wi, qr, sg, ckvr, ckv, ki, kr, vr, qlat, mix, kvs, hb1, hdn, list_tok, tok_e, tok_pos, tok_gate, end; };
constexpr WsMap make_map() {
    WsMap m{}; size_t o = 0;
    m.bar = o; o += al256(65536); m.ctl = o; o += al256(1 << 20); m.rot = o; o += al256((size_t)T * 32 * 8);
    m.WinT = o; o += al256((size_t)NL * DINP * D * 2); m.WoT = o; o += al256((size_t)NL * D * D * 2);
    m.WukT = o; o += al256((size_t)NL * 8 * 128 * 64 * 2); m.WuvT = o; o += al256((size_t)NL * 8 * 64 * 128 * 2);
    m.WrHi = o; o += al256((size_t)NL * 64 * D * 2); m.WrLo = o; o += al256((size_t)NL * 64 * D * 2);
    m.W1T = o; o += al256((size_t)NL * 65 * 512 * D * 2); m.W2T = o; o += al256((size_t)NL * 65 * D * 256 * 2);
    m.hb = o; o += al256((size_t)MP * D * 2);
    m.U = o; o += al256((size_t)RMAX * D * 2);
    const size_t oA = o;
    m.qa = o; o += al256((size_t)MP * 512 * 2); m.qi = o; o += al256((size_t)MP * 512 * 2); m.wi = o; o += al256((size_t)MP * 8 * 4);
    m.qr = o; o += al256((size_t)MP * 256 * 2); m.sg = o; o += al256((size_t)MP * 512 * 2);
    m.ckvr = o; o += al256((size_t)KVR * 128 * 2); m.ckv = o; o += al256((size_t)KVR * 128 * 2); m.ki = o; o += al256((size_t)(KVR + 512) * 64 * 2);
    m.kr = o; o += al256((size_t)KVR * 256 * 2); m.vr = o; o += al256((size_t)KVR * 512 * 2);
    m.qlat = o; o += al256((size_t)MP * 1024 * 2); m.mix = o; o += al256((size_t)MP * 1024 * 2); m.kvs = o; o += al256((size_t)BATCH * 4 * 17 * 8192 * 4);
    const size_t endA = o; o = oA;
    m.hb1 = o; o += al256((size_t)MP * D * 2); m.hdn = o; o += al256((size_t)RMAX * DE * 2);
    m.list_tok = o; o += al256((size_t)NE * LSTRIDE * 4);
    m.tok_e = o; o += al256((size_t)MP * 8 * 4); m.tok_pos = o; o += al256((size_t)MP * 8 * 4); m.tok_gate = o; o += al256((size_t)MP * 8 * 4);
    m.end = endA > o ? endA : o;
    return m;
}
constexpr WsMap WS = make_map();
struct MegaArgs { const float* in[20]; float* out; char* ws; };
#ifndef REP_MASK
#define REP_MASK 0
#endif
#define REPS(k) (((REP_MASK >> (k)) & 1) ? 2 : 1)
#ifndef USE_CG_SYNC
#define USE_CG_SYNC 1
#endif
#define GRID_SYNC() do { xcd_barrier(xbar); } while (0)
constexpr int L_XB = 160512;
constexpr size_t BAR_BYTES = 16384;
__global__ void __launch_bounds__(512, 2) mega(MegaArgs A) {
    extern __shared__ __attribute__((aligned(16))) unsigned char dynlds[];
    LAS unsigned char* lds = (LAS unsigned char*)dynlds;
    cg::grid_group grid = cg::this_grid();
    char* ws = A.ws;
    if (threadIdx.x < 2) ((LAS unsigned*)(lds + L_XB))[threadIdx.x] = 0u;
    __syncthreads();
    const XcdBarrier xbar = xcd_barrier_post((unsigned*)(ws + WS.bar), (volatile LAS unsigned*)(lds + L_XB));
#define WSP(T, f) ((T*)(ws + WS.f))
#define FRESH() do { size_t z_ = 0; asm volatile("" : "+s"(z_)); ws = A.ws + z_; asm volatile("" : "+s"(l)); } while (0)
    { ProArgs a; a.x = A.in[0]; a.meta = A.in[1]; a.w_in = A.in[2]; a.w_uk = A.in[3]; a.w_uv = A.in[4]; a.w_o = A.in[7]; a.w_router = A.in[10]; a.w_gate = A.in[12]; a.w_up = A.in[13]; a.w_down = A.in[14];
      a.ws_gate = A.in[15]; a.ws_up = A.in[16]; a.ws_down = A.in[17]; a.hb = WSP(bf16_t, hb); a.rot = WSP(f32x2, rot); a.WinT = WSP(bf16_t, WinT); a.WoT = WSP(bf16_t, WoT); a.WukT = WSP(bf16_t, WukT); a.WuvT = WSP(bf16_t, WuvT);
      a.WrHi = WSP(bf16_t, WrHi); a.WrLo = WSP(bf16_t, WrLo); a.W1T = WSP(bf16_t, W1T); a.W2T = WSP(bf16_t, W2T); a.ctl = WSP(int, ctl);
      for (int rep = 0; rep < REPS(0); ++rep) { if (rep) GRID_SYNC(); phase_prologue(lds, a); } }
    grid.sync();
#pragma unroll 1
    for (int l = 0; l < NL; ++l) {
        FRESH();
        { InProjArgs a; a.hb = WSP(bf16_t, hb); a.WinT = WSP(bf16_t, WinT) + (size_t)l * DINP * D; a.qa = WSP(bf16_t, qa); a.qi = WSP(bf16_t, qi); a.qr = WSP(bf16_t, qr); a.kr = WSP(bf16_t, kr); a.vr = WSP(bf16_t, vr); a.sg = WSP(bf16_t, sg);
          a.ckvr = WSP(bf16_t, ckvr); a.ki = WSP(bf16_t, ki); a.wi = WSP(float, wi); a.rot = WSP(f32x2, rot);
          for (int rep = 0; rep < REPS(1); ++rep) { if (rep) GRID_SYNC(); phase_inproj(lds, a); } }
        GRID_SYNC(); FRESH();
        { Pre2Args a; a.ckvr = WSP(bf16_t, ckvr); a.kvw = A.in[5] + (size_t)l * 128; a.ckv = WSP(bf16_t, ckv); a.qa = WSP(bf16_t, qa); a.WukT = WSP(bf16_t, WukT) + (size_t)l * 8 * 128 * 64; a.qlat = WSP(bf16_t, qlat);
          for (int rep = 0; rep < REPS(10); ++rep) { if (rep) GRID_SYNC(); phase_pre2(a); } }
        ret::Args ra; ra.qr = WSP(bf16_t, qr); ra.kr = WSP(bf16_t, kr); ra.vr = WSP(bf16_t, vr); ra.sg = WSP(bf16_t, sg); ra.rw = A.in[6] + (size_t)l * 512; ra.kvs = WSP(float, kvs); ra.mix = WSP(bf16_t, mix);
        for (int rep = 0; rep < REPS(2); ++rep) { if (rep) GRID_SYNC(); ret::phase_r1(lds, ra); }
        GRID_SYNC(); FRESH();
        ra.qr = WSP(bf16_t, qr); ra.kr = WSP(bf16_t, kr); ra.vr = WSP(bf16_t, vr); ra.sg = WSP(bf16_t, sg); ra.rw = A.in[6] + (size_t)l * 512; ra.kvs = WSP(float, kvs); ra.mix = WSP(bf16_t, mix);
        for (int rep = 0; rep < REPS(3); ++rep) { if (rep) GRID_SYNC(); ret::phase_r2(lds, ra); }
        { attn::Args a; a.qi = WSP(bf16_t, qi); a.wi = WSP(float, wi); a.ki = WSP(bf16_t, ki); a.qlat = WSP(bf16_t, qlat); a.ckv = WSP(bf16_t, ckv); a.WuvT = WSP(bf16_t, WuvT) + (size_t)l * 8 * 64 * 128; a.mix = WSP(bf16_t, mix);
          for (int rep = 0; rep < REPS(9); ++rep) { if (rep) GRID_SYNC(); attn::phase(lds, a); } }
        GRID_SYNC(); FRESH();
        { OutProjArgs a; a.mix = WSP(bf16_t, mix); a.WoT = WSP(bf16_t, WoT) + (size_t)l * D * D; a.h = WSP(bf16_t, hb); a.y = WSP(float, U);
          for (int rep = 0; rep < REPS(4); ++rep) { if (rep) GRID_SYNC(); phase_outproj(lds, a, MP / 256); } }
        GRID_SYNC(); FRESH();
        { int* cnt = WSP(int, ctl) + l * 64; route::Args a; a.y1 = WSP(float, U); a.g = A.in[8] + (size_t)l * D; a.bta = A.in[9] + (size_t)l * D; a.WrHi = WSP(bf16_t, WrHi) + (size_t)l * 64 * D; a.WrLo = WSP(bf16_t, WrLo) + (size_t)l * 64 * D; a.rbias = A.in[11] + (size_t)l * NE;
          a.hb1 = WSP(bf16_t, hb1); a.cnt = cnt; a.list_tok = WSP(int, list_tok); a.tok_e = WSP(int, tok_e); a.tok_pos = WSP(int, tok_pos); a.tok_gate = WSP(float, tok_gate);
          route::phase(lds, a); }
        GRID_SYNC(); FRESH();
        MoeArgs ma; { int* cnt = WSP(int, ctl) + l * 64; ma.cnt = cnt; } ma.hb1 = WSP(bf16_t, hb1); ma.W1T = WSP(bf16_t, W1T) + (size_t)l * 65 * 512 * D; ma.W2T = WSP(bf16_t, W2T) + (size_t)l * 65 * D * DE; ma.hdn = WSP(bf16_t, hdn); ma.yrows = WSP(bf16_t, U); ma.list_tok = WSP(int, list_tok);
        for (int rep = 0; rep < REPS(6); ++rep) { if (rep) GRID_SYNC(); phase_moe1(lds, ma); }
        GRID_SYNC(); FRESH();
        ma.cnt = WSP(int, ctl) + l * 64; ma.hb1 = WSP(bf16_t, hb1); ma.W1T = WSP(bf16_t, W1T) + (size_t)l * 65 * 512 * D; ma.W2T = WSP(bf16_t, W2T) + (size_t)l * 65 * D * DE; ma.hdn = WSP(bf16_t, hdn); ma.yrows = WSP(bf16_t, U); ma.list_tok = WSP(int, list_tok);
        for (int rep = 0; rep < REPS(7); ++rep) { if (rep) GRID_SYNC(); phase_moe2(lds, ma); }
        GRID_SYNC(); FRESH();
        { int* cnt = WSP(int, ctl) + l * 64; CombArgs a; a.hb1 = WSP(bf16_t, hb1); a.yrows = WSP(bf16_t, U); a.cnt = cnt; a.tok_e = WSP(int, tok_e); a.tok_pos = WSP(int, tok_pos); a.tok_gate = WSP(float, tok_gate); a.g = A.in[18] + (size_t)l * D; a.bta = A.in[19] + (size_t)l * D;
          a.hb = WSP(bf16_t, hb); a.out = l == NL - 1 ? A.out : nullptr;
          for (int rep = 0; rep < REPS(8); ++rep) { if (rep) GRID_SYNC(); phase_combine(lds, a); } }
        GRID_SYNC();
    }
#undef WSP
}
extern "C" void kernel_launch(void* const* d_in, const int* in_sizes, int n_in, void* d_out, int out_size, void* d_ws, size_t ws_size, hipStream_t stream) {
    static int grid_blocks = 0;
    if (grid_blocks == 0) {
        if (WS.end > ws_size || n_in != 20) { fprintf(stderr, "kernel_launch: workspace too small (%zu > %zu) or bad n_in %d\n", (size_t)WS.end, ws_size, n_in); grid_blocks = -1; return; }
        if (hipFuncSetAttribute((const void*)mega, hipFuncAttributeMaxDynamicSharedMemorySize, LDS_BYTES) != hipSuccess) { fprintf(stderr, "hipFuncSetAttribute failed\n"); grid_blocks = -1; return; }
        int dev = 0, cus = 0, per_cu = 0;
        (void)hipGetDevice(&dev); (void)hipDeviceGetAttribute(&cus, hipDeviceAttributeMultiprocessorCount, dev);
        (void)hipOccupancyMaxActiveBlocksPerMultiprocessor(&per_cu, (const void*)mega, 512, LDS_BYTES);
        if (per_cu < 1 || cus < 1) { fprintf(stderr, "kernel_launch: occupancy query failed (%d CUs, %d per CU)\n", cus, per_cu); grid_blocks = -1; return; }
        grid_blocks = cus;
        if (grid_blocks != 256) fprintf(stderr, "kernel_launch: note: %d CUs (tuned for 256)\n", grid_blocks);
    }
    if (grid_blocks < 0) return;
    if (hipMemsetAsync((char*)d_ws + WS.bar, 0, 65536, stream) != hipSuccess) { fprintf(stderr, "kernel_launch: memset of the barrier words failed\n"); return; }
    MegaArgs a; memset(&a, 0, sizeof(a));
    for (int i = 0; i < 20; ++i) a.in[i] = (const float*)d_in[i];
    a.out = (float*)d_out; a.ws = (char*)d_ws;
    void* args[] = {&a};
    hipError_t e = hipLaunchCooperativeKernel((const void*)mega, dim3(grid_blocks), dim3(512), args, LDS_BYTES, stream);
    if (e != hipSuccess) fprintf(stderr, "cooperative launch failed: %s (grid %d)\n", hipGetErrorString(e), grid_blocks);
}
```

```cpp
#include <hip/hip_runtime.h>
#include <hip/hip_cooperative_groups.h>
#include <stdint.h>
#include <stdio.h>
#include <string.h>
namespace cg = cooperative_groups;

typedef unsigned short bf16_t;
typedef short bf16x8 __attribute__((ext_vector_type(8)));
typedef float f32x16 __attribute__((ext_vector_type(16)));
typedef float f32x4 __attribute__((ext_vector_type(4)));
typedef float f32x2 __attribute__((ext_vector_type(2)));
typedef unsigned u32x4 __attribute__((ext_vector_type(4)));
typedef unsigned u32x2 __attribute__((ext_vector_type(2)));
#define LAS __attribute__((address_space(3)))

constexpr int D = 1024, BATCH = 8, SEQ = 2048, NMETA = 16, T = SEQ + NMETA, NL = 4;
constexpr int MR = BATCH * SEQ, MT = MR + NMETA, MP = 65 * 256, KVR = BATCH * T;
constexpr int DIN = 2760, DINP = 2816;
constexpr int NE = 64, TOPK = 8, DE = 256;
constexpr int NSEL = 256;
constexpr int C_QA = 0, C_CKV = 512, C_QI = 640, C_KI = 1152, C_WI = 1216, C_QR = 1224, C_KR = 1480, C_VR = 1736, C_GR = 2248;
constexpr float DN_ALPHA = 1.681792830507429f;
constexpr float EPS = 1e-6f;

__device__ __forceinline__ int fresh_tid() { int t = threadIdx.x; asm volatile("" : "+v"(t)); return t; }
__device__ __forceinline__ int fresh_bid() { int b = blockIdx.x; asm volatile("" : "+s"(b)); return b; }
__device__ __forceinline__ bf16_t f2bf(float f) { unsigned u = __float_as_uint(f); return (bf16_t)((u + 0x7fffu + ((u >> 16) & 1u)) >> 16); }
__device__ __forceinline__ float bf2f(bf16_t h) { return __uint_as_float(((unsigned)h) << 16); }
__device__ __forceinline__ unsigned pk2(float lo, float hi) { return (unsigned)f2bf(lo) | ((unsigned)f2bf(hi) << 16); }
__device__ __forceinline__ u32x4 pk8(f32x4 a, f32x4 b) { u32x4 w; w.x = pk2(a[0], a[1]); w.y = pk2(a[2], a[3]); w.z = pk2(b[0], b[1]); w.w = pk2(b[2], b[3]); return w; }
__device__ __forceinline__ float ret_log2_gamma(int hh) { const float xh = -3.4657359027997265f + (float)hh * (-0.9241962407465937f); return log2f(1.f - expf(xh)); }
__device__ __forceinline__ float siluf(float g) { return g / (1.f + __expf(-g)); }
__host__ __device__ __forceinline__ int win_src_col(int n) {
    if (n < 512) return C_QA + n;
    if (n < 1024) return C_QI + (n - 512);
    if (n < 1536) { int c = n - 1024; const int isk = c >> 8; c &= 255; const int half = c >> 7, cc = c & 127, hh = cc >> 5, i = cc & 31; return (isk ? C_KR : C_QR) + hh * 64 + half * 32 + i; }
    if (n < 2048) return C_VR + (n - 1536);
    if (n < 2560) return C_GR + (n - 2048);
    const int c = n - 2560; if (c < 128) return C_CKV + c; if (c < 192) return C_KI + (c - 128); if (c < 200) return C_WI + (c - 192); return -1;
}
#define GAS __attribute__((address_space(1)))

#define XB_TMO      128
#define XB_XCNT(j)  (256  + 64 * (j))
#define XB_XSUB(j)  (1280 + 64 * (j))
#define XB_XGEN(j)  (2304 + 64 * (j))
#define XB_TOP      3328
#define XB_TOPGEN   3392
#define XCD_BAR_WORDS 3456
#define XB_SPIN_CAP (1u << 18)

__device__ __forceinline__ unsigned xb_ld(unsigned* p)              { return __hip_atomic_load(p, __ATOMIC_RELAXED, __HIP_MEMORY_SCOPE_AGENT); }
__device__ __forceinline__ unsigned xb_add(unsigned* p, unsigned v) { return __hip_atomic_fetch_add(p, v, __ATOMIC_RELAXED, __HIP_MEMORY_SCOPE_AGENT); }
__device__ __forceinline__ unsigned xb_xcc_id() { return (unsigned)__builtin_amdgcn_s_getreg((3 << 11) | 20) & 0xFu; }
#define XB_SPIN(cond, bar) do { unsigned _sp = 0; while (cond) { __builtin_amdgcn_s_sleep(1); \
    if ((++_sp & 255u) == 0u) { if (xb_ld(&(bar)[XB_TMO])) break; if (_sp > XB_SPIN_CAP) { atomicAdd(&(bar)[XB_TMO], 1u); break; } } } } while (0)

struct XcdBarrier {
    unsigned* bar; unsigned x;
    volatile LAS unsigned* st;
};

__device__ __forceinline__ XcdBarrier xcd_barrier_post(unsigned* bar, volatile LAS unsigned* st) {
    XcdBarrier b; b.bar = bar; b.x = xb_xcc_id(); b.st = st;
    if (threadIdx.x == 0) (void)xb_add(&bar[XB_XCNT(b.x)], 1u);
    return b;
}
__device__ __forceinline__ void xcd_barrier_complete(unsigned* bar, unsigned x, unsigned& nloc, unsigned& nx) {
    const unsigned G = gridDim.x * gridDim.y * gridDim.z;
    unsigned sum, cnt, mine, sp = 0u;
    for (;;) {
        sum = 0u; cnt = 0u; mine = 0u;
#pragma unroll
        for (unsigned j = 0; j < 16; ++j) { const unsigned c = xb_ld(&bar[XB_XCNT(j)]); sum += c; cnt += (c > 0u) ? 1u : 0u; mine = (j == x) ? c : mine; }
        if (sum == G) break;
        __builtin_amdgcn_s_sleep(1);
        if ((++sp & 255u) == 0u) { if (xb_ld(&bar[XB_TMO])) break; if (sp > XB_SPIN_CAP) { atomicAdd(&bar[XB_TMO], 1u); break; } }
    }
    nloc = mine > 0u ? mine : 1u; nx = cnt > 0u ? cnt : 1u;
}

__device__ __forceinline__ void xcd_barrier(const XcdBarrier& b) {
    asm volatile("s_waitcnt vmcnt(0)" ::: "memory");
    __syncthreads();
    if (threadIdx.x == 0) {
        unsigned* bar = b.bar;
        __builtin_amdgcn_s_waitcnt(0);
        unsigned nloc = b.st[0], nx = b.st[1];
        if (nloc == 0u) { xcd_barrier_complete(bar, b.x, nloc, nx); b.st[0] = nloc; b.st[1] = nx; }
        const unsigned old = xb_add(&bar[XB_XSUB(b.x)], 1u);
        const unsigned gen = old / nloc;
        if (old + 1u == (gen + 1u) * nloc) {
            __builtin_amdgcn_fence(__ATOMIC_RELEASE, "agent");
            asm volatile("s_waitcnt vmcnt(0)" ::: "memory");
            const unsigned og = xb_add(&bar[XB_TOP], 1u);
            const unsigned tg = og / nx;
            if (og + 1u == (tg + 1u) * nx) xb_add(&bar[XB_TOPGEN], 1u);
            else XB_SPIN(xb_ld(&bar[XB_TOPGEN]) == tg, bar);
            __builtin_amdgcn_fence(__ATOMIC_ACQUIRE, "agent");
            xb_add(&bar[XB_XGEN(b.x)], 1u);
            asm volatile("s_waitcnt vmcnt(0)" ::: "memory");
        } else {
            XB_SPIN(xb_ld(&bar[XB_XGEN(b.x)]) == gen, bar);
            __builtin_amdgcn_fence(__ATOMIC_ACQUIRE, "agent");
            asm volatile("s_waitcnt vmcnt(0)" ::: "memory");
        }
    }
    __syncthreads();
}

namespace pg8 {
#define PG8_LAS __attribute__((address_space(3)))
constexpr int BM = 256, BK = 64, HALF = 128, HTB = HALF * BK * 2  , STAGE_BYTES = 8 * HTB;

__host__ __device__ __forceinline__ int lds_byte(int r, int c) { const int st = (r >> 4) * 2 + (c >> 5), rr = r & 15, cc = c & 31, ob = rr * 64 + cc * 2; return st * 1024 + (ob ^ (((ob >> 9) & 1) << 5)); }
__host__ __device__ __forceinline__ void stage_rc(int b, int& R, int& C) { const int st = b / 1024, sb = b % 1024, swz = sb ^ (((sb >> 9) & 1) << 5); R = (st >> 1) * 16 + swz / 64; C = (st & 1) * 32 + (swz % 64) / 2; }
__host__ __device__ __forceinline__ int perm32(int rho) { const int n = rho >> 4, i = rho & 15; return 8 * (i >> 2) + 4 * n + (i & 3); }

struct Unit { int pm, pn, aux, lt, nval; };

template <class Epi, class Sched, bool ALIGN_EPI>
__device__ __forceinline__ void gemm_phase(PG8_LAS unsigned char* lds, const int K, const Sched& S, const Epi& E) {
    const int tid = fresh_tid(), wid = __builtin_amdgcn_readfirstlane(tid >> 6), lane = tid & 63, wr = wid >> 2, wc = wid & 3, fr = lane & 15, fq = lane >> 4;
    const int nt = K / BK;
    const unsigned rowb = (unsigned)K * 2u;
    int Rr[2]; unsigned Cb[2], voffB[2];
#pragma unroll
    for (int i = 0; i < 2; ++i) { int R, C; stage_rc(tid * 16 + i * 8192, R, C); const int Rb = Epi::PERM ? ((R & ~31) + perm32(R & 31)) : R;
        Rr[i] = R; Cb[i] = (unsigned)C * 2u; voffB[i] = (unsigned)Rb * rowb + (unsigned)C * 2u; }
    const size_t kstep = (size_t)(BK * 2);
    const size_t hstep = (size_t)HALF * K * 2;
    const unsigned ldsw = (unsigned)wid * 1024u;
    const int aoff = lds_byte(wr * 64 + fr, fq * 8), boff = lds_byte(wc * 32 + fr, fq * 8);
#define PG8_SA(b, h) (((b) * 2 + (h)) * HTB)
#define PG8_SB(b, h) ((4 + (b) * 2 + (h)) * HTB)
#define PG8_STAGE(bufoff, gbase, voff) do { _Pragma("unroll") for (int _i = 0; _i < 2; ++_i) \
        __builtin_amdgcn_global_load_lds((const unsigned*)((const char*)(gbase) + (voff)[_i]), (PG8_LAS unsigned*)(lds + (bufoff) + ldsw + _i * 8192), 16, 0, 0); } while (0)
#define PG8_SETA(v, u) do { if constexpr (Sched::GATHER) { _Pragma("unroll") for (int _h = 0; _h < 2; ++_h) _Pragma("unroll") for (int _i = 0; _i < 2; ++_i) \
            v[_h][_i] = (unsigned)S.arow(u, 128 * _h + Rr[_i]) * rowb + Cb[_i]; } \
        else { _Pragma("unroll") for (int _h = 0; _h < 2; ++_h) _Pragma("unroll") for (int _i = 0; _i < 2; ++_i) v[_h][_i] = (unsigned)(128 * _h + Rr[_i]) * rowb + Cb[_i]; } } while (0)
#define PG8_LDA(dst, b, h) do { _Pragma("unroll") for (int m = 0; m < 4; ++m) _Pragma("unroll") for (int k = 0; k < 2; ++k) dst[m][k] = *(const PG8_LAS bf16x8*)(lds + PG8_SA(b, h) + aoff + m * 2048 + k * 1024); } while (0)
#define PG8_LDB(dst, b, h) do { _Pragma("unroll") for (int n = 0; n < 2; ++n) _Pragma("unroll") for (int k = 0; k < 2; ++k) dst[n][k] = *(const PG8_LAS bf16x8*)(lds + PG8_SB(b, h) + boff + n * 2048 + k * 1024); } while (0)
#define PG8_MMA(ai, bj, At, Bt) do { __builtin_amdgcn_s_setprio(1); _Pragma("unroll") for (int m = 0; m < 4; ++m) _Pragma("unroll") for (int n = 0; n < 2; ++n) _Pragma("unroll") for (int k = 0; k < 2; ++k) \
        acc[ai][bj][m][n] = __builtin_amdgcn_mfma_f32_16x16x32_bf16(Bt[n][k], At[m][k], acc[ai][bj][m][n], 0, 0, 0); __builtin_amdgcn_s_setprio(0); } while (0)
#define PG8_WAIT_V(n) asm volatile("s_waitcnt vmcnt(" #n ")" ::: "memory")
#define PG8_WAIT_L(n) asm volatile("s_waitcnt lgkmcnt(" #n ")" ::: "memory")
#define PG8_BAR __builtin_amdgcn_s_barrier()
#define PG8_SCHED __builtin_amdgcn_sched_barrier(0)
    Unit cur, nxt; int ui = 0;
    if (!S.next(0, cur)) return;
    f32x4 acc[2][2][4][2];
#pragma unroll
    for (int a = 0; a < 2; ++a)
#pragma unroll
        for (int b = 0; b < 2; ++b)
#pragma unroll
            for (int m = 0; m < 4; ++m)
#pragma unroll
                for (int n = 0; n < 2; ++n) acc[a][b][m][n] = (f32x4){0.f, 0.f, 0.f, 0.f};
    bf16x8 At[4][2], B0[2][2], B1[2][2];
    unsigned vAc[2][2], vAn[2][2];
    const char* cA = S.a_base(cur); const char* cB = S.b_base(cur);
    PG8_SETA(vAc, cur);
    PG8_STAGE(PG8_SB(0, 0), cB, voffB); PG8_STAGE(PG8_SB(0, 1), cB + hstep, voffB); PG8_STAGE(PG8_SA(0, 0), cA, vAc[0]); PG8_STAGE(PG8_SA(0, 1), cA, vAc[1]);
    if (wr == 1) PG8_BAR;
    PG8_WAIT_V(2); PG8_BAR;
    PG8_STAGE(PG8_SB(1, 0), cB + kstep, voffB); PG8_STAGE(PG8_SA(1, 0), cA + kstep, vAc[0]); PG8_STAGE(PG8_SB(1, 1), cB + hstep + kstep, voffB);
    PG8_WAIT_V(6); PG8_BAR;
    for (;;) {
        const bool has_next = S.next(ui + 1, nxt);
        const char* nA = has_next ? S.a_base(nxt) : cA; const char* nB = has_next ? S.b_base(nxt) : cB;
        if (has_next) { PG8_SETA(vAn, nxt); } else {
#pragma unroll
            for (int h = 0; h < 2; ++h)
#pragma unroll
                for (int i = 0; i < 2; ++i) vAn[h][i] = vAc[h][i]; }
#pragma unroll 1
        for (int t = 0; t < nt; t += 2) {
            const bool last = (t == nt - 2);
            const char* a1 = cA + (size_t)(t + 1) * kstep;
            const char* a2 = last ? nA : cA + (size_t)(t + 2) * kstep; const char* b2 = last ? nB : cB + (size_t)(t + 2) * kstep;
            const char* a3 = a2 + kstep; const char* b3 = b2 + kstep;
            unsigned v2[2][2];
#pragma unroll
            for (int h = 0; h < 2; ++h)
#pragma unroll
                for (int i = 0; i < 2; ++i) v2[h][i] = last ? vAn[h][i] : vAc[h][i];
            PG8_LDB(B0, 0, 0); PG8_LDB(B1, 0, 1); PG8_SCHED; PG8_LDA(At, 0, 0); PG8_STAGE(PG8_SA(1, 1), a1, vAc[1]);
            PG8_WAIT_V(8); PG8_WAIT_L(0); PG8_BAR; PG8_MMA(0, 0, At, B0); PG8_MMA(0, 1, At, B1); PG8_BAR; PG8_SCHED;
            PG8_LDA(At, 0, 1); PG8_STAGE(PG8_SB(0, 0), b2, voffB); PG8_STAGE(PG8_SB(0, 1), b2 + hstep, voffB); PG8_STAGE(PG8_SA(0, 0), a2, v2[0]);
            PG8_WAIT_V(8); PG8_WAIT_L(0); PG8_BAR; PG8_MMA(1, 0, At, B0); PG8_MMA(1, 1, At, B1); PG8_BAR; PG8_SCHED;
            PG8_LDB(B0, 1, 0); PG8_LDB(B1, 1, 1); PG8_SCHED; PG8_LDA(At, 1, 0); PG8_STAGE(PG8_SA(0, 1), a2, v2[1]);
            PG8_WAIT_V(8); PG8_WAIT_L(0); PG8_BAR; PG8_MMA(0, 0, At, B0); PG8_MMA(0, 1, At, B1); PG8_BAR; PG8_SCHED;
            PG8_LDA(At, 1, 1); PG8_STAGE(PG8_SB(1, 0), b3, voffB); PG8_STAGE(PG8_SB(1, 1), b3 + hstep, voffB); PG8_STAGE(PG8_SA(1, 0), a3, v2[0]);
            PG8_WAIT_V(8); PG8_WAIT_L(0); PG8_BAR; PG8_MMA(1, 0, At, B0); PG8_MMA(1, 1, At, B1); PG8_BAR; PG8_SCHED;
        }
        if constexpr (ALIGN_EPI) { if (wr == 0) PG8_BAR; }
        E(acc, cur, wr, wc, fr, fq);
        if (!has_next) break;
#pragma unroll
        for (int a = 0; a < 2; ++a)
#pragma unroll
            for (int b = 0; b < 2; ++b)
#pragma unroll
                for (int m = 0; m < 4; ++m)
#pragma unroll
                    for (int n = 0; n < 2; ++n) acc[a][b][m][n] = (f32x4){0.f, 0.f, 0.f, 0.f};
        cur = nxt; cA = nA; cB = nB; ++ui;
#pragma unroll
        for (int h = 0; h < 2; ++h)
#pragma unroll
            for (int i = 0; i < 2; ++i) vAc[h][i] = vAn[h][i];
        if constexpr (ALIGN_EPI) { if (wr == 1) PG8_BAR; }
    }
    PG8_WAIT_V(0);
    if constexpr (!ALIGN_EPI) { if (wr == 0) PG8_BAR; }
    PG8_BAR;
#undef PG8_SA
#undef PG8_SB
#undef PG8_STAGE
#undef PG8_SETA
#undef PG8_LDA
#undef PG8_LDB
#undef PG8_MMA
#undef PG8_WAIT_V
#undef PG8_WAIT_L
#undef PG8_BAR
#undef PG8_SCHED
}
}
constexpr int NXCD = 8, WGM = 8;
struct DenseSched {
    static constexpr bool GATHER = false;
    const char* A; const char* Bt; size_t tstep; int nM, nN, nwg, G, c;
    __device__ __forceinline__ void init(const bf16_t* A_, const bf16_t* Bt_, int K, int nM_, int nN_, int G_, int c_) { A = (const char*)A_; Bt = (const char*)Bt_; tstep = (size_t)256 * K * 2; nM = nM_; nN = nN_; nwg = nM * nN; G = G_; c = c_; }
    __device__ __forceinline__ bool next(int i, pg8::Unit& u) const {
        const long L = (long)i * G + c; if (L >= nwg) return false;
        int wgid = (int)L; { const int q = nwg / NXCD, r = nwg % NXCD, xcd = wgid % NXCD, off = wgid / NXCD; wgid = (xcd < r ? xcd * (q + 1) : r * (q + 1) + (xcd - r) * q) + off; }
        const int nig = WGM * nN, gid = wgid / nig, fm = gid * WGM, gsz = (nM - fm) < WGM ? (nM - fm) : WGM;
        u.pm = fm + ((wgid % nig) % gsz); u.pn = (wgid % nig) / gsz; u.aux = 0; u.lt = 0; u.nval = 256; return true;
    }
    __device__ __forceinline__ const char* a_base(const pg8::Unit& u) const { return A + (size_t)u.pm * tstep; }
    __device__ __forceinline__ const char* b_base(const pg8::Unit& u) const { return Bt + (size_t)u.pn * tstep; }
    __device__ __forceinline__ int arow(const pg8::Unit&, int i) const { return i; }
};

__device__ __forceinline__ void st16(bf16_t* p, u32x4 v) { *(u32x4*)p = v; }
struct EpiInProj {
    static constexpr bool PERM = true;
    bf16_t *qa, *qi, *qr, *kr, *vr, *sg, *ckvr, *ki; float* wi; const f32x2* rot;
    __device__ __forceinline__ void operator()(const f32x4 (&acc)[2][2][4][2], const pg8::Unit& u, int wr, int wc, int fr, int fq) const {
        const int pn = u.pn, cw = 32 * wc + 8 * fq;
        const float lg = ret_log2_gamma(wc);
#pragma unroll
        for (int ai = 0; ai < 2; ++ai)
#pragma unroll
            for (int m = 0; m < 4; ++m) {
                const int r = u.pm * 256 + ai * 128 + wr * 64 + m * 16 + fr;
                if (r >= MT) continue;
                const int p = r < MR ? NMETA + (r & (SEQ - 1)) : r - MR;
                const int nrep = r < MR ? 1 : BATCH;
                const int kv0 = r < MR ? (r >> 11) * T + p : p;
                if (pn < 2) { st16(qa + (size_t)r * 512 + 256 * pn + cw, pk8(acc[ai][0][m][0], acc[ai][0][m][1])); st16(qa + (size_t)r * 512 + 256 * pn + 128 + cw, pk8(acc[ai][1][m][0], acc[ai][1][m][1])); }
                else if (pn < 4) { st16(qi + (size_t)r * 512 + 256 * (pn - 2) + cw, pk8(acc[ai][0][m][0], acc[ai][0][m][1])); st16(qi + (size_t)r * 512 + 256 * (pn - 2) + 128 + cw, pk8(acc[ai][1][m][0], acc[ai][1][m][1])); }
                else if (pn < 6) {
                    const int nl = (p + 112) & 127;
                    const float sc = pn == 4 ? exp2f((float)nl * lg) : 0.125f * exp2f(-(float)nl * lg);
                    f32x4 o1[2], o2[2];
#pragma unroll
                    for (int n = 0; n < 2; ++n)
#pragma unroll
                        for (int j = 0; j < 4; ++j) { const f32x2 cs = rot[p * 32 + 8 * fq + 4 * n + j]; const float x1 = acc[ai][0][m][n][j], x2 = acc[ai][1][m][n][j];
                            o1[n][j] = (x1 * cs.x - x2 * cs.y) * sc; o2[n][j] = (x1 * cs.y + x2 * cs.x) * sc; }
                    const u32x4 w1 = pk8(o1[0], o1[1]), w2 = pk8(o2[0], o2[1]);
                    if (pn == 4) { st16(qr + (size_t)r * 256 + wc * 64 + 8 * fq, w1); st16(qr + (size_t)r * 256 + wc * 64 + 32 + 8 * fq, w2); }
                    else for (int rep = 0; rep < nrep; ++rep) { bf16_t* d = kr + (size_t)(kv0 + rep * T) * 256 + wc * 64 + 8 * fq; st16(d, w1); st16(d + 32, w2); }
                }
                else if (pn < 8) { const u32x4 w1 = pk8(acc[ai][0][m][0], acc[ai][0][m][1]), w2 = pk8(acc[ai][1][m][0], acc[ai][1][m][1]);
                    for (int rep = 0; rep < nrep; ++rep) { bf16_t* d = vr + (size_t)(kv0 + rep * T) * 512 + 256 * (pn - 6) + cw; st16(d, w1); st16(d + 128, w2); } }
                else if (pn < 10) {
                    f32x4 s[2][2];
#pragma unroll
                    for (int bj = 0; bj < 2; ++bj)
#pragma unroll
                        for (int n = 0; n < 2; ++n)
#pragma unroll
                            for (int j = 0; j < 4; ++j) s[bj][n][j] = siluf(acc[ai][bj][m][n][j]);
                    st16(sg + (size_t)r * 512 + 256 * (pn - 8) + cw, pk8(s[0][0], s[0][1])); st16(sg + (size_t)r * 512 + 256 * (pn - 8) + 128 + cw, pk8(s[1][0], s[1][1]));
                }
                else {
                    const u32x4 w1 = pk8(acc[ai][0][m][0], acc[ai][0][m][1]), w2 = pk8(acc[ai][1][m][0], acc[ai][1][m][1]);
                    for (int rep = 0; rep < nrep; ++rep) { st16(ckvr + (size_t)(kv0 + rep * T) * 128 + cw, w1); if (wc < 2) st16(ki + (size_t)(kv0 + rep * T) * 64 + cw, w2); }
                    if (wc == 2 && fq == 0) { *(f32x4*)(wi + (size_t)r * 8) = acc[ai][1][m][0] * 0.35355339059327373f; *(f32x4*)(wi + (size_t)r * 8 + 4) = acc[ai][1][m][1] * 0.35355339059327373f; }
                }
            }
    }
};
struct InProjArgs { const bf16_t* hb; const bf16_t* WinT; bf16_t *qa, *qi, *qr, *kr, *vr, *sg, *ckvr, *ki; float* wi; const f32x2* rot; };
__device__ __forceinline__ void phase_inproj(LAS unsigned char* lds, const InProjArgs& a) {
    DenseSched S; S.init(a.hb, a.WinT, D, MP / 256, DINP / 256, (int)gridDim.x, fresh_bid());
    EpiInProj E; E.qa = a.qa; E.qi = a.qi; E.qr = a.qr; E.kr = a.kr; E.vr = a.vr; E.sg = a.sg; E.ckvr = a.ckvr; E.ki = a.ki; E.wi = a.wi; E.rot = a.rot;
    pg8::gemm_phase<EpiInProj, DenseSched, true>(lds, D, S, E);
}
struct EpiOutProj {
    static constexpr bool PERM = false;
    const bf16_t* h; float* y;
    __device__ __forceinline__ void operator()(const f32x4 (&acc)[2][2][4][2], const pg8::Unit& u, int wr, int wc, int fr, int fq) const {
#pragma unroll
        for (int ai = 0; ai < 2; ++ai)
#pragma unroll
            for (int m = 0; m < 4; ++m) {
                const int r = u.pm * 256 + ai * 128 + wr * 64 + m * 16 + fr; if (r >= MT) continue;
#pragma unroll
                for (int bj = 0; bj < 2; ++bj)
#pragma unroll
                    for (int n = 0; n < 2; ++n) { const size_t i = (size_t)r * D + u.pn * 256 + bj * 128 + wc * 32 + n * 16 + fq * 4; const u32x2 hv = *(const u32x2*)(h + i);
                        const f32x4 hf4 = (f32x4){bf2f((bf16_t)(hv.x & 0xffff)), bf2f((bf16_t)(hv.x >> 16)), bf2f((bf16_t)(hv.y & 0xffff)), bf2f((bf16_t)(hv.y >> 16))}; *(f32x4*)(y + i) = hf4 * DN_ALPHA + acc[ai][bj][m][n]; }
            }
    }
};
struct OutProjArgs { const bf16_t* mix; const bf16_t* WoT; const bf16_t* h; float* y; };
__device__ __forceinline__ void phase_outproj(LAS unsigned char* lds, const OutProjArgs& a, int nM) {
    DenseSched S; S.init(a.mix, a.WoT, D, nM, D / 256, (int)gridDim.x, fresh_bid());
    EpiOutProj E; E.h = a.h; E.y = a.y;
    pg8::gemm_phase<EpiOutProj, DenseSched, true>(lds, D, S, E);
}

constexpr int MAXT = 644;
constexpr int RMAX = MAXT * 256;
__device__ __forceinline__ int xcd_vcu(int bx, int G) { return (G % 8 == 0) ? (bx % 8) * (G / 8) + bx / 8 : bx; }
constexpr int LSTRIDE = MP;
constexpr int L_TF = 159744;
__device__ __forceinline__ void moe_tile_prefix(LAS unsigned char* lds, const int* cnt) {
    LAS int* tf = (LAS int*)(lds + L_TF);
    __syncthreads();
    const int tid_ = fresh_tid();
    if (tid_ < 64) {
        const int e = tid_; const int nt = (cnt[e] + 255) >> 8; int incl = nt;
#pragma unroll
        for (int o = 1; o < 64; o <<= 1) { const int v = __shfl_up(incl, o); if (e >= o) incl += v; }
        tf[e] = incl - nt; if (e == 63) { tf[64] = incl; tf[65] = incl + MP / 256; }
    }
    __syncthreads();
}
template <bool GATH, int NPN>
struct MoeSched {
    static constexpr bool GATHER = GATH;
    const char* A; const char* Wt; const int* list_tok; const int* cnt; LAS const int* tf; size_t estride, tstepB, tstepA; int nunits, G, vcu;
    __device__ __forceinline__ bool next(int i, pg8::Unit& u) const {
        const int L = i * G + vcu; if (L >= nunits) return false; u.pm = L / NPN; u.pn = L % NPN;
        int lo = 0, hi = 64;
        while (lo < hi) { const int mid = (lo + hi + 1) >> 1; if (tf[mid] <= u.pm) lo = mid; else hi = mid - 1; }
        u.aux = lo; u.lt = 0; u.nval = 256;
        if constexpr (GATH) { u.lt = u.pm - tf[lo]; const int c = lo < 64 ? cnt[lo] : MT; const int rem = c - 256 * u.lt; u.nval = rem < 256 ? rem : 256; }
        return true;
    }
    __device__ __forceinline__ const char* a_base(const pg8::Unit& u) const { return GATH ? A : A + (size_t)u.pm * tstepA; }
    __device__ __forceinline__ const char* b_base(const pg8::Unit& u) const { return Wt + (size_t)u.aux * estride + (size_t)u.pn * tstepB; }
    __device__ __forceinline__ int arow(const pg8::Unit& u, int i) const { if (i >= u.nval) return 0; return u.aux < 64 ? list_tok[(size_t)u.aux * LSTRIDE + u.lt * 256 + i] : u.lt * 256 + i; }
};
struct EpiSwiglu8 {
    static constexpr bool PERM = true;
    bf16_t* hdn;
    __device__ __forceinline__ void operator()(const f32x4 (&acc)[2][2][4][2], const pg8::Unit& u, int wr, int wc, int fr, int fq) const {
#pragma unroll
        for (int ai = 0; ai < 2; ++ai)
#pragma unroll
            for (int m = 0; m < 4; ++m) {
                const size_t r = (size_t)u.pm * 256 + ai * 128 + wr * 64 + m * 16 + fr;
                f32x4 s[2];
#pragma unroll
                for (int n = 0; n < 2; ++n)
#pragma unroll
                    for (int j = 0; j < 4; ++j) s[n][j] = siluf(acc[ai][0][m][n][j]) * acc[ai][1][m][n][j];
                st16(hdn + r * DE + u.pn * 128 + wc * 32 + fq * 8, pk8(s[0], s[1]));
            }
    }
};
struct EpiRows8 {
    static constexpr bool PERM = true;
    bf16_t* y;
    __device__ __forceinline__ void operator()(const f32x4 (&acc)[2][2][4][2], const pg8::Unit& u, int wr, int wc, int fr, int fq) const {
#pragma unroll
        for (int ai = 0; ai < 2; ++ai)
#pragma unroll
            for (int m = 0; m < 4; ++m) {
                const size_t r = (size_t)u.pm * 256 + ai * 128 + wr * 64 + m * 16 + fr;
#pragma unroll
                for (int bj = 0; bj < 2; ++bj) st16(y + r * D + u.pn * 256 + bj * 128 + wc * 32 + fq * 8, pk8(acc[ai][bj][m][0], acc[ai][bj][m][1]));
            }
    }
};
struct MoeArgs { const bf16_t* hb1; const bf16_t* W1T; const bf16_t* W2T; bf16_t* hdn; bf16_t* yrows; const int* list_tok; const int* cnt; };
__device__ __forceinline__ void phase_moe1(LAS unsigned char* lds, const MoeArgs& a) {
    moe_tile_prefix(lds, a.cnt);
    MoeSched<true, 2> S; S.A = (const char*)a.hb1; S.Wt = (const char*)a.W1T; S.list_tok = a.list_tok; S.cnt = a.cnt; S.tf = (LAS const int*)(lds + L_TF); S.estride = (size_t)512 * D * 2; S.tstepB = (size_t)256 * D * 2; S.tstepA = 0;
    S.nunits = S.tf[65] * 2; S.G = (int)gridDim.x; S.vcu = xcd_vcu(fresh_bid(), (int)gridDim.x);
    EpiSwiglu8 E; E.hdn = a.hdn;
    pg8::gemm_phase<EpiSwiglu8, MoeSched<true, 2>, true>(lds, D, S, E);
}
__device__ __forceinline__ void phase_moe2(LAS unsigned char* lds, const MoeArgs& a) {
    moe_tile_prefix(lds, a.cnt);
    MoeSched<false, 4> S; S.A = (const char*)a.hdn; S.Wt = (const char*)a.W2T; S.list_tok = a.list_tok; S.cnt = a.cnt; S.tf = (LAS const int*)(lds + L_TF); S.estride = (size_t)D * DE * 2; S.tstepB = (size_t)256 * DE * 2; S.tstepA = (size_t)256 * DE * 2;
    S.nunits = S.tf[65] * 4; S.G = (int)gridDim.x; S.vcu = xcd_vcu(fresh_bid(), (int)gridDim.x);
    EpiRows8 E; E.y = a.yrows;
    pg8::gemm_phase<EpiRows8, MoeSched<false, 4>, true>(lds, DE, S, E);
}
__device__ __forceinline__ float wave_sum(float v) {
#pragma unroll
    for (int o = 1; o < 64; o <<= 1) v += __shfl_xor(v, o);
    return v;
}
__device__ __forceinline__ void unpack8(u32x4 w, float* f) { f[0] = bf2f((bf16_t)(w.x & 0xffff)); f[1] = bf2f((bf16_t)(w.x >> 16)); f[2] = bf2f((bf16_t)(w.y & 0xffff)); f[3] = bf2f((bf16_t)(w.y >> 16));
    f[4] = bf2f((bf16_t)(w.z & 0xffff)); f[5] = bf2f((bf16_t)(w.z >> 16)); f[6] = bf2f((bf16_t)(w.w & 0xffff)); f[7] = bf2f((bf16_t)(w.w >> 16)); }

struct Pre2Args { const bf16_t* ckvr; const float* kvw; bf16_t* ckv; const bf16_t* qa; const bf16_t* WukT; bf16_t* qlat; };
__device__ __forceinline__ void phase_pre2(const Pre2Args& a) {
    const int tid = fresh_tid(), lane = tid & 63, w = tid >> 6, gw = fresh_bid() * 8 + w, ngw = gridDim.x * 8;
    for (int row = gw; row < KVR; row += ngw) {
        const unsigned x = *(const unsigned*)(a.ckvr + (size_t)row * 128 + lane * 2);
        const float c0 = bf2f((bf16_t)(x & 0xffff)), c1 = bf2f((bf16_t)(x >> 16));
        const float rs = rsqrtf(wave_sum(c0 * c0 + c1 * c1) * (1.f / 128.f) + EPS);
        *(unsigned*)(a.ckv + (size_t)row * 128 + lane * 2) = pk2(c0 * rs * a.kvw[lane * 2], c1 * rs * a.kvw[lane * 2 + 1]);
    }
    const int r32 = lane & 31, hi = lane >> 5;
    for (int u = gw; u < ((MT + 31) / 32) * 8; u += ngw) {
        const int rt = u >> 3, h = u & 7; const int row = rt * 32 + r32, rowc = row < MT ? row : MT - 1;
        bf16x8 Af[4];
#pragma unroll
        for (int ks = 0; ks < 4; ++ks) Af[ks] = *(const bf16x8*)(a.qa + (size_t)rowc * 512 + h * 64 + ks * 16 + hi * 8);
#pragma unroll
        for (int nt = 0; nt < 4; ++nt) {
            f32x16 acc;
#pragma unroll
            for (int i = 0; i < 16; ++i) acc[i] = 0.f;
#pragma unroll
            for (int ks = 0; ks < 4; ++ks) { const bf16x8 Bf = *(const bf16x8*)(a.WukT + ((size_t)h * 128 + nt * 32 + r32) * 64 + ks * 16 + hi * 8); acc = __builtin_amdgcn_mfma_f32_32x32x16_bf16(Af[ks], Bf, acc, 0, 0, 0); }
#pragma unroll
            for (int i = 0; i < 16; ++i) { const int rr = rt * 32 + (i & 3) + 8 * (i >> 2) + 4 * hi; if (rr < MT) a.qlat[(size_t)rr * 1024 + h * 128 + nt * 32 + r32] = f2bf(acc[i] * 0.125f); }
        }
    }
}

namespace route {
constexpr int AP = 2064;
constexpr int L_AHI = 0, L_ALO = 32 * AP, L_PART = 0  , L_LOG = 2 * 32 * AP  , L_CNT = L_LOG + 8192, L_BASE = L_CNT + 256, L_ENT = L_BASE + 256, L_END = L_ENT + 96 * 8 * 4;
struct Args { const float* y1; const float* g; const float* bta; const bf16_t* WrHi; const bf16_t* WrLo; const float* rbias; bf16_t* hb1; int* cnt; int* list_tok; int* tok_e; int* tok_pos; float* tok_gate; };
__device__ __forceinline__ void group(LAS unsigned char* lds, const Args& a, const int row0, const int nvalid, const int gi) {
    const int tid = fresh_tid(), lane = tid & 63, w = tid >> 6, r32 = lane & 31, hi = lane >> 5;
    __syncthreads();
    for (int q = 0; q < 4; ++q) {
        const int tl = 4 * w + q, row = row0 + tl;
        f32x4 v[4];
        if (tl < nvalid) {
#pragma unroll
            for (int j = 0; j < 4; ++j) v[j] = *(const f32x4*)(a.y1 + (size_t)row * D + 256 * j + lane * 4);
            float s = 0.f;
#pragma unroll
            for (int j = 0; j < 4; ++j) s += (v[j][0] + v[j][1]) + (v[j][2] + v[j][3]);
            const float mu = wave_sum(s) * (1.f / D); float s2 = 0.f;
#pragma unroll
            for (int j = 0; j < 4; ++j) { v[j] = v[j] - mu; s2 += (v[j][0] * v[j][0] + v[j][1] * v[j][1]) + (v[j][2] * v[j][2] + v[j][3] * v[j][3]); }
            const float rstd = rsqrtf(wave_sum(s2) * (1.f / D) + EPS);
#pragma unroll
            for (int j = 0; j < 4; ++j) v[j] = v[j] * rstd * *(const f32x4*)(a.g + 256 * j + lane * 4) + *(const f32x4*)(a.bta + 256 * j + lane * 4);
        } else {
#pragma unroll
            for (int j = 0; j < 4; ++j) v[j] = (f32x4){0.f, 0.f, 0.f, 0.f};
        }
#pragma unroll
        for (int j = 0; j < 4; ++j) {
            u32x2 h2; h2.x = pk2(v[j][0], v[j][1]); h2.y = pk2(v[j][2], v[j][3]);
            const float r0 = v[j][0] - bf2f((bf16_t)(h2.x & 0xffff)), r1 = v[j][1] - bf2f((bf16_t)(h2.x >> 16)), r2 = v[j][2] - bf2f((bf16_t)(h2.y & 0xffff)), r3 = v[j][3] - bf2f((bf16_t)(h2.y >> 16));
            u32x2 l2; l2.x = pk2(r0, r1); l2.y = pk2(r2, r3);
            if (tl < nvalid) *(u32x2*)(a.hb1 + (size_t)row * D + 256 * j + lane * 4) = h2;
            *(LAS u32x2*)(lds + L_AHI + tl * AP + (256 * j + lane * 4) * 2) = h2; *(LAS u32x2*)(lds + L_ALO + tl * AP + (256 * j + lane * 4) * 2) = l2;
        }
    }
    __syncthreads();
    f32x16 acc[2];
#pragma unroll
    for (int nt = 0; nt < 2; ++nt)
#pragma unroll
        for (int i = 0; i < 16; ++i) acc[nt][i] = 0.f;
#pragma unroll
    for (int ks = 0; ks < 8; ++ks) {
        const int k0 = 128 * w + 16 * ks + 8 * hi;
        const bf16x8 Ah = *(const LAS bf16x8*)(lds + L_AHI + r32 * AP + k0 * 2), Al = *(const LAS bf16x8*)(lds + L_ALO + r32 * AP + k0 * 2);
#pragma unroll
        for (int nt = 0; nt < 2; ++nt) {
            const bf16x8 Bh = *(const bf16x8*)(a.WrHi + (size_t)(nt * 32 + r32) * D + k0), Bl = *(const bf16x8*)(a.WrLo + (size_t)(nt * 32 + r32) * D + k0);
            acc[nt] = __builtin_amdgcn_mfma_f32_32x32x16_bf16(Ah, Bh, acc[nt], 0, 0, 0);
            acc[nt] = __builtin_amdgcn_mfma_f32_32x32x16_bf16(Al, Bh, acc[nt], 0, 0, 0);
            acc[nt] = __builtin_amdgcn_mfma_f32_32x32x16_bf16(Ah, Bl, acc[nt], 0, 0, 0);
        }
    }
    __syncthreads();
#pragma unroll
    for (int nt = 0; nt < 2; ++nt)
#pragma unroll
        for (int i = 0; i < 16; ++i) { const int tk = (i & 3) + 8 * (i >> 2) + 4 * hi; *(LAS float*)(lds + L_PART + w * 8192 + (tk * 64 + nt * 32 + r32) * 4) = acc[nt][i]; }
    __syncthreads();
    { f32x4 s = *(const LAS f32x4*)(lds + L_PART + tid * 16);
#pragma unroll
      for (int ww = 1; ww < 8; ++ww) s += *(const LAS f32x4*)(lds + L_PART + ww * 8192 + tid * 16);
      *(LAS f32x4*)(lds + L_LOG + tid * 16) = s; }
    __syncthreads();
    for (int q = 0; q < 4; ++q) {
        const int tl = 4 * w + q, row = row0 + tl; if (tl >= nvalid) break;
        const float lg = *(const LAS float*)(lds + L_LOG + (tl * 64 + lane) * 4);
        const float score = 1.f / (1.f + expf(-lg)), sel = score + a.rbias[lane];
        const int gidx = lane >> 3;
        float m1 = sel; m1 = fmaxf(m1, __shfl_xor(m1, 1)); m1 = fmaxf(m1, __shfl_xor(m1, 2)); m1 = fmaxf(m1, __shfl_xor(m1, 4));
        const unsigned long long eq = __ballot(sel == m1); const unsigned gb = (unsigned)(eq >> (8 * gidx)) & 0xffu; const int first = __ffs(gb) - 1;
        float m2 = ((lane & 7) == first) ? -INFINITY : sel; m2 = fmaxf(m2, __shfl_xor(m2, 1)); m2 = fmaxf(m2, __shfl_xor(m2, 2)); m2 = fmaxf(m2, __shfl_xor(m2, 4));
        const float gs = m1 + m2;
        int grank = 0;
#pragma unroll
        for (int g2 = 0; g2 < 8; ++g2) { const float gv = __shfl(gs, 8 * g2); grank += (gv > gs || (gv == gs && g2 < gidx)) ? 1 : 0; }
        const float selv = grank < 4 ? sel : -INFINITY;
        int erank = 0;
        for (int e2 = 0; e2 < 64; ++e2) { const float ev = __shfl(selv, e2); erank += (ev > selv || (ev == selv && e2 < lane)) ? 1 : 0; }
        const bool take = grank < 4 && erank < 8;
        const float ssum = wave_sum(take ? score : 0.f);
        if (take) {
            const int lr = __hip_atomic_fetch_add((LAS int*)(lds + L_CNT) + lane, 1, __ATOMIC_RELAXED, __HIP_MEMORY_SCOPE_WORKGROUP);
            a.tok_e[row * 8 + erank] = lane; a.tok_gate[row * 8 + erank] = score / ssum * 2.5f;
            *(LAS unsigned*)(lds + L_ENT + ((gi * 32 + tl) * 8 + erank) * 4) = (unsigned)lane | ((unsigned)lr << 8);
        }
    }
}
__device__ __forceinline__ void phase(LAS unsigned char* lds, const Args& a) {
    const int tid = fresh_tid();
    for (int c = fresh_bid(); c < 256; c += gridDim.x) {
        __syncthreads();
        if (tid < 64) ((LAS int*)(lds + L_CNT))[tid] = 0;
        const int ng = c == 0 ? 3 : 2;
#pragma unroll 1
        for (int gi = 0; gi < ng; ++gi) group(lds, a, gi < 2 ? 64 * c + 32 * gi : MR, gi < 2 ? 32 : NMETA, gi);
        __syncthreads();
        if (tid < 64) ((LAS int*)(lds + L_BASE))[tid] = atomicAdd(a.cnt + tid, ((LAS int*)(lds + L_CNT))[tid]);
        __syncthreads();
        for (int i = tid; i < ng * 32 * 8; i += 512) {
            const int gi = i >> 8, tl = (i >> 3) & 31, slot = i & 7; if (gi == 2 && tl >= NMETA) continue;
            const int row = gi < 2 ? 64 * c + 32 * gi + tl : MR + tl;
            const unsigned en = *(const LAS unsigned*)(lds + L_ENT + i * 4); const int e = en & 0xff, pos = ((const LAS int*)(lds + L_BASE))[e] + (int)(en >> 8);
            a.tok_pos[row * 8 + slot] = pos; a.list_tok[(size_t)e * LSTRIDE + pos] = row;
        }
    }
    __syncthreads();
}
}

struct CombArgs { const bf16_t* hb1; const bf16_t* yrows; const int* cnt; const int* tok_e; const int* tok_pos; const float* tok_gate; const float* g; const float* bta; bf16_t* hb; float* out; };
__device__ __forceinline__ void phase_combine(LAS unsigned char* lds, const CombArgs& a) {
    moe_tile_prefix(lds, a.cnt);
    LAS const int* tf = (LAS const int*)(lds + L_TF);
    const int tid = fresh_tid(), lane = tid & 63, w = tid >> 6, gw = fresh_bid() * 8 + w, ngw = gridDim.x * 8;
    for (int row = gw; row < MT; row += ngw) {
        const int4 e0 = *(const int4*)(a.tok_e + row * 8), e1 = *(const int4*)(a.tok_e + row * 8 + 4), p0 = *(const int4*)(a.tok_pos + row * 8), p1 = *(const int4*)(a.tok_pos + row * 8 + 4);
        const f32x4 g0v = *(const f32x4*)(a.tok_gate + row * 8), g1v = *(const f32x4*)(a.tok_gate + row * 8 + 4);
        size_t rr[9]; float gt[9];
        rr[0] = (size_t)tf[e0.x] * 256 + p0.x; rr[1] = (size_t)tf[e0.y] * 256 + p0.y; rr[2] = (size_t)tf[e0.z] * 256 + p0.z; rr[3] = (size_t)tf[e0.w] * 256 + p0.w;
        rr[4] = (size_t)tf[e1.x] * 256 + p1.x; rr[5] = (size_t)tf[e1.y] * 256 + p1.y; rr[6] = (size_t)tf[e1.z] * 256 + p1.z; rr[7] = (size_t)tf[e1.w] * 256 + p1.w; rr[8] = (size_t)tf[64] * 256 + row;
        gt[0] = g0v[0]; gt[1] = g0v[1]; gt[2] = g0v[2]; gt[3] = g0v[3]; gt[4] = g1v[0]; gt[5] = g1v[1]; gt[6] = g1v[2]; gt[7] = g1v[3]; gt[8] = 1.f;
        u32x4 ld[10][2];
        ld[9][0] = *(const u32x4*)(a.hb1 + (size_t)row * D + lane * 8); ld[9][1] = *(const u32x4*)(a.hb1 + (size_t)row * D + 512 + lane * 8);
#pragma unroll
        for (int k = 0; k < 9; ++k) { ld[k][0] = *(const u32x4*)(a.yrows + rr[k] * D + lane * 8); ld[k][1] = *(const u32x4*)(a.yrows + rr[k] * D + 512 + lane * 8); }
        float y[16];
        { float t[8]; unpack8(ld[9][0], t);
#pragma unroll
          for (int i = 0; i < 8; ++i) y[i] = t[i] * DN_ALPHA;
          unpack8(ld[9][1], t);
#pragma unroll
          for (int i = 0; i < 8; ++i) y[8 + i] = t[i] * DN_ALPHA; }
#pragma unroll
        for (int k = 0; k < 9; ++k) {
            float t[8]; unpack8(ld[k][0], t);
#pragma unroll
            for (int i = 0; i < 8; ++i) y[i] += gt[k] * t[i];
            unpack8(ld[k][1], t);
#pragma unroll
            for (int i = 0; i < 8; ++i) y[8 + i] += gt[k] * t[i];
        }
        float s = 0.f;
#pragma unroll
        for (int i = 0; i < 16; ++i) s += y[i];
        const float mu = wave_sum(s) * (1.f / D); float s2 = 0.f;
#pragma unroll
        for (int i = 0; i < 16; ++i) { y[i] -= mu; s2 += y[i] * y[i]; }
        const float rstd = rsqrtf(wave_sum(s2) * (1.f / D) + EPS);
#pragma unroll
        for (int hlf = 0; hlf < 2; ++hlf) {
            const int c0 = 512 * hlf + lane * 8;
            const f32x4 g0 = *(const f32x4*)(a.g + c0), g1 = *(const f32x4*)(a.g + c0 + 4), b0 = *(const f32x4*)(a.bta + c0), b1 = *(const f32x4*)(a.bta + c0 + 4);
            f32x4 o0, o1;
#pragma unroll
            for (int i = 0; i < 4; ++i) { o0[i] = y[8 * hlf + i] * rstd * g0[i] + b0[i]; o1[i] = y[8 * hlf + 4 + i] * rstd * g1[i] + b1[i]; }
            *(u32x4*)(a.hb + (size_t)row * D + c0) = pk8(o0, o1);
            if (a.out && row < MR) { *(f32x4*)(a.out + (size_t)row * D + c0) = o0; *(f32x4*)(a.out + (size_t)row * D + c0 + 4) = o1; }
        }
    }
}
struct TrJob { const float* W; bf16_t* Wt; size_t w_zstride, wt_zstride; int K, N, ldwt, G, gstride, row_off, nz, pad; };
__device__ __forceinline__ int tr_items(const TrJob& j) { return (j.K / 64) * (j.N / 32) * j.nz; }
__device__ __forceinline__ void tr_item(LAS float* scr, const TrJob& j, int item, int lane) {
    const int nb = j.N / 32, kb = j.K / 64, per = nb * kb, z = item / per, r = item % per, k0 = (r / nb) * 64, n0 = (r % nb) * 32;
    const float* W = j.W + (size_t)z * j.w_zstride; bf16_t* Wt = j.Wt + (size_t)z * j.wt_zstride;
#pragma unroll 8
    for (int i = 0; i < 32; ++i) { const int kk = 2 * i + (lane >> 5); scr[kk * 33 + (lane & 31)] = W[(size_t)(k0 + kk) * j.N + n0 + (lane & 31)]; }
    asm volatile("s_waitcnt lgkmcnt(0)" ::: "memory");
    const int c = lane & 7;
#pragma unroll
    for (int q = 0; q < 4; ++q) { const int n = (lane >> 3) + 8 * q; const LAS float* s = scr + (8 * c) * 33 + n;
        u32x4 o; o.x = pk2(s[0 * 33], s[1 * 33]); o.y = pk2(s[2 * 33], s[3 * 33]); o.z = pk2(s[4 * 33], s[5 * 33]); o.w = pk2(s[6 * 33], s[7 * 33]);
        const int nn = n0 + n, dn = (nn / j.G) * j.gstride + (nn % j.G) + j.row_off;
        *(u32x4*)(Wt + (size_t)dn * j.ldwt + k0 + 8 * c) = o; }
    asm volatile("s_waitcnt lgkmcnt(0)" ::: "memory");
}
__device__ __forceinline__ TrJob mk_job(const float* W, bf16_t* Wt, int K, int N, size_t wz, size_t wtz, int ldwt, int G, int gstride, int row_off, int nz) {
    TrJob j; j.W = W; j.Wt = Wt; j.w_zstride = wz; j.wt_zstride = wtz; j.K = K; j.N = N; j.ldwt = ldwt; j.G = G; j.gstride = gstride; j.row_off = row_off; j.nz = nz; j.pad = 0; return j;
}
struct ProArgs { const float* x; const float* meta; const float* w_in; const float* w_uk; const float* w_uv; const float* w_o; const float* w_router; const float* w_gate; const float* w_up; const float* w_down;
                 const float* ws_gate; const float* ws_up; const float* ws_down; bf16_t* hb; f32x2* rot; bf16_t* WinT; bf16_t* WoT; bf16_t* WukT; bf16_t* WuvT; bf16_t* WrHi; bf16_t* WrLo; bf16_t* W1T; bf16_t* W2T; int* ctl; };
__device__ __forceinline__ void phase_prologue(LAS unsigned char* lds, const ProArgs& a) {
    const int tid = fresh_tid(), lane = tid & 63, w = tid >> 6, bid = fresh_bid(), gw = bid * 8 + w, ngw = gridDim.x * 8;
    const size_t gt = (size_t)bid * 512 + tid, ngt = (size_t)gridDim.x * 512;
    if (bid == 0) for (int i = tid; i < 4096; i += 512) a.ctl[i] = 0;
    for (size_t i = gt; i < (size_t)MP * D / 8; i += ngt) { const size_t e = i * 8; const int row = (int)(e / D), col = (int)(e % D);
        f32x4 v0 = (f32x4){0.f, 0.f, 0.f, 0.f}, v1 = v0;
        if (row < MR) { v0 = *(const f32x4*)(a.x + e); v1 = *(const f32x4*)(a.x + e + 4); } else if (row < MT) { v0 = *(const f32x4*)(a.meta + (size_t)(row - MR) * D + col); v1 = *(const f32x4*)(a.meta + (size_t)(row - MR) * D + col + 4); }
        *(u32x4*)(a.hb + e) = pk8(v0, v1); }
    for (size_t i = gt; i < (size_t)T * 32; i += ngt) { const int p = (int)(i >> 5), j = (int)(i & 31); const float inv = exp2f(-(float)j * (13.287712379549449f / 32.f)); float sn, cs; sincosf((float)p * inv, &sn, &cs); a.rot[i] = (f32x2){cs, sn}; }
    for (size_t i = gt; i < (size_t)NL * 64 * D; i += ngt) { const int l = (int)(i / (64 * D)), r = (int)(i % (64 * D)), e = r / D, k = r % D; const float v = a.w_router[((size_t)l * D + k) * 64 + e];
        const bf16_t h = f2bf(v); a.WrHi[i] = h; a.WrLo[i] = f2bf(v - bf2f(h)); }
    LAS float* scr = (LAS float*)lds + w * (64 * 33);
    for (int it = gw; it < NL * (DINP / 32) * (D / 64); it += ngw) {
        const int l = it / ((DINP / 32) * (D / 64)), r = it % ((DINP / 32) * (D / 64)), n0 = (r % (DINP / 32)) * 32, k0 = (r / (DINP / 32)) * 64;
        const int sc = win_src_col(n0 + (lane & 31)); const float* W = a.w_in + (size_t)l * D * DIN;
#pragma unroll 8
        for (int i = 0; i < 32; ++i) { const int kk = 2 * i + (lane >> 5); scr[kk * 33 + (lane & 31)] = sc >= 0 ? W[(size_t)(k0 + kk) * DIN + sc] : 0.f; }
        asm volatile("s_waitcnt lgkmcnt(0)" ::: "memory");
        const int c = lane & 7;
#pragma unroll
        for (int q = 0; q < 4; ++q) { const int n = (lane >> 3) + 8 * q; const LAS float* s = scr + (8 * c) * 33 + n;
            u32x4 o; o.x = pk2(s[0 * 33], s[1 * 33]); o.y = pk2(s[2 * 33], s[3 * 33]); o.z = pk2(s[4 * 33], s[5 * 33]); o.w = pk2(s[6 * 33], s[7 * 33]);
            *(u32x4*)(a.WinT + ((size_t)l * DINP + n0 + n) * D + k0 + 8 * c) = o; }
        asm volatile("s_waitcnt lgkmcnt(0)" ::: "memory");
    }
#define RUN_JOB(J) do { const TrJob _j = (J); const int _n = tr_items(_j); for (int it = gw; it < _n; it += ngw) tr_item(scr, _j, it, lane); } while (0)
    RUN_JOB(mk_job(a.w_o, a.WoT, D, D, (size_t)D * D, (size_t)D * D, D, D, 0, 0, NL));
    RUN_JOB(mk_job(a.w_uk, a.WukT, 64, 128, 64 * 128, 128 * 64, 64, 128, 0, 0, NL * 8));
    RUN_JOB(mk_job(a.w_uv, a.WuvT, 128, 64, 128 * 64, 64 * 128, 128, 64, 0, 0, NL * 8));
    for (int l = 0; l < NL; ++l) {
        bf16_t* W1 = a.W1T + (size_t)l * 65 * 512 * D; bf16_t* W2 = a.W2T + (size_t)l * 65 * D * DE;
        RUN_JOB(mk_job(a.w_gate + (size_t)l * NE * D * DE, W1, D, DE, (size_t)D * DE, (size_t)512 * D, D, 128, 256, 0, NE));
        RUN_JOB(mk_job(a.w_up + (size_t)l * NE * D * DE, W1, D, DE, (size_t)D * DE, (size_t)512 * D, D, 128, 256, 128, NE));
        RUN_JOB(mk_job(a.ws_gate + (size_t)l * D * DE, W1 + (size_t)NE * 512 * D, D, DE, 0, 0, D, 128, 256, 0, 1));
        RUN_JOB(mk_job(a.ws_up + (size_t)l * D * DE, W1 + (size_t)NE * 512 * D, D, DE, 0, 0, D, 128, 256, 128, 1));
        RUN_JOB(mk_job(a.w_down + (size_t)l * NE * DE * D, W2, DE, D, (size_t)DE * D, (size_t)D * DE, DE, D, 0, 0, NE));
        RUN_JOB(mk_job(a.ws_down + (size_t)l * DE * D, W2 + (size_t)NE * D * DE, DE, D, 0, 0, DE, D, 0, 0, 1));
    }
#undef RUN_JOB
}
namespace attn {
constexpr int NP_MAX = 33, NCH = 9;
constexpr int KI_PITCH = 144;
constexpr int L_KI = 0, L_GATH = 0, L_OLDS = 65536, OL_PITCH = 2064, L_LIST = L_OLDS + 32 * OL_PITCH  , L_WQ = L_LIST + 8 * 4 * 256 * 2  , L_END = L_WQ + 1024;
typedef short v4i16_t __attribute__((ext_vector_type(4)));
__device__ __forceinline__ unsigned off_b(unsigned row, unsigned ch) { return 256u * row + 16u * (ch ^ (((row & 3) << 2) | ((row >> 2) & 3))); }
__device__ __forceinline__ float relu0(float x) { return __builtin_amdgcn_fmed3f(x, 0.f, INFINITY); }
__device__ __forceinline__ unsigned fkey20(float f, int kidx) { unsigned u = __float_as_uint(f); u = (u & 0x80000000u) ? ~u : (u | 0x80000000u); return (u & 0xFFFFF000u) | (unsigned)(4095 - kidx); }

struct Args { const bf16_t* qi; const float* wi; const bf16_t* ki; const bf16_t* qlat; const bf16_t* ckv; const bf16_t* WuvT; bf16_t* mix; };

__device__ __forceinline__ void unit(LAS unsigned char* lds, const Args& a, const int b, const int row0, const int p0, const int nq) {
    int tid = threadIdx.x; asm volatile("" : "+v"(tid));
    const int lane = tid & 63, w = __builtin_amdgcn_readfirstlane(tid >> 6), r32 = lane & 31, hi = lane >> 5;
    const int nk = p0 + nq, ntile = (nk + 31) >> 5;
    const size_t kvb = (size_t)b * T;
    unsigned u[4][NP_MAX];
#pragma unroll
    for (int q = 0; q < 4; ++q)
#pragma unroll
        for (int j = 0; j < NP_MAX; ++j) u[q][j] = 0u;
    const int npair = (ntile + 1) >> 1;
    {
        const int qa_ = 4 * w + (r32 >> 3); const int qrow = row0 + (qa_ < nq ? qa_ : 0);
        bf16x8 Af[4];
#pragma unroll
        for (int ks = 0; ks < 4; ++ks) Af[ks] = *(const bf16x8*)(a.qi + (size_t)qrow * 512 + (r32 & 7) * 64 + ks * 16 + hi * 8);
        float wq[4][4];
#pragma unroll
        for (int q = 0; q < 4; ++q) { const int ql = 4 * w + q; const f32x4 t = *(const f32x4*)(a.wi + (size_t)(row0 + (ql < nq ? ql : 0)) * 8 + 4 * hi); wq[q][0] = t[0]; wq[q][1] = t[1]; wq[q][2] = t[2]; wq[q][3] = t[3]; }
        const int pw0 = p0 + 4 * w;
        const unsigned char* kst = (const unsigned char*)(a.ki + kvb * 64) + (size_t)(tid >> 3) * 128 + (tid & 7) * 16;
        unsigned koff = 0;
        const unsigned lst = L_KI + (tid >> 3) * KI_PITCH + (tid & 7) * 16;
#pragma unroll
        for (int c = 0; c < NCH; ++c) {
            if (c * 8 < ntile) {
                __syncthreads();
#pragma unroll
                for (int j = 0; j < 4; ++j) *(LAS u32x4*)(lds + lst + j * 64 * KI_PITCH) = *(const u32x4*)(kst + koff + j * 8192);
                koff += 32768; asm volatile("" : "+v"(koff));
                __syncthreads();
#pragma unroll
                for (int jj = 0; jj < 4; ++jj) {
                    const int j = c * 4 + jj;
                    if (j < NP_MAX && j < npair) {
                        bf16x8 Bf[2][4];
#pragma unroll
                        for (int t = 0; t < 2; ++t)
#pragma unroll
                            for (int ks = 0; ks < 4; ++ks) Bf[t][ks] = *(const LAS bf16x8*)(lds + L_KI + ((2 * jj + t) * 32 + r32) * KI_PITCH + ks * 32 + hi * 16);
                        f32x16 acc[2];
#pragma unroll
                        for (int t = 0; t < 2; ++t)
#pragma unroll
                            for (int i = 0; i < 16; ++i) acc[t][i] = 0.f;
#pragma unroll
                        for (int ks = 0; ks < 4; ++ks)
#pragma unroll
                            for (int t = 0; t < 2; ++t) acc[t] = __builtin_amdgcn_mfma_f32_32x32x16_bf16(Af[ks], Bf[t][ks], acc[t], 0, 0, 0);
                        const int kidx = 64 * j + lane;
#pragma unroll
                        for (int q = 0; q < 4; ++q) {
                            float pa = 0.f, pb = 0.f;
#pragma unroll
                            for (int i = 0; i < 4; ++i) { pa += wq[q][i] * relu0(acc[0][4 * q + i]); pb += wq[q][i] * relu0(acc[1][4 * q + i]); }
                            const auto rr = __builtin_amdgcn_permlane32_swap(__float_as_uint(pa), __float_as_uint(pb), false, false);
                            const float sc = __uint_as_float(rr[0]) + __uint_as_float(rr[1]);
                            u[q][j] = (4 * w + q < nq && kidx <= pw0 + q) ? fkey20(sc, kidx) : 0u;
                        }
                    }
                }
            }
        }
        __syncthreads();
        unsigned Tq[4], pre[4]; bool dn[4]; bool any = false;
#pragma unroll
        for (int q = 0; q < 4; ++q) { Tq[q] = 1u; pre[q] = 0u; const bool need = (4 * w + q < nq) && (pw0 + q + 1 > NSEL); dn[q] = !need; any = any || need; }
        if (any) {
#pragma unroll 1
            for (int bit = 31; bit >= 0; --bit) {
                int n[4]; unsigned cd[4];
#pragma unroll
                for (int q = 0; q < 4; ++q) { n[q] = 0; cd[q] = pre[q] | (1u << bit); }
#pragma unroll
                for (int c = 0; c < NCH; ++c) if (c * 4 < npair) {
#pragma unroll
                    for (int jj = 0; jj < 4; ++jj) if (c * 4 + jj < NP_MAX) {
#pragma unroll
                        for (int q = 0; q < 4; ++q) n[q] += __builtin_popcountll(__ballot(u[q][c * 4 + jj] >= cd[q])); } }
                bool all = true;
#pragma unroll
                for (int q = 0; q < 4; ++q) { if (!dn[q]) { if (n[q] >= NSEL) pre[q] = cd[q]; if (n[q] == NSEL) { Tq[q] = cd[q]; dn[q] = true; } } all = all && dn[q]; }
                if (all) break;
            }
#pragma unroll
            for (int q = 0; q < 4; ++q) if (!dn[q]) Tq[q] = pre[q];
        }
        int base[4] = {0, 0, 0, 0};
#pragma unroll
        for (int c = 0; c < NCH; ++c) if (c * 4 < npair) {
#pragma unroll
            for (int jj = 0; jj < 4; ++jj) if (c * 4 + jj < NP_MAX) { const int j = c * 4 + jj;
#pragma unroll
                for (int q = 0; q < 4; ++q) {
                    const bool f = u[q][j] >= Tq[q]; const unsigned long long m = __ballot(f);
                    const int pp = __builtin_amdgcn_mbcnt_hi((unsigned)(m >> 32), __builtin_amdgcn_mbcnt_lo((unsigned)m, 0u));
                    if (f) ((LAS unsigned short*)(lds + L_LIST) + (w * 4 + q) * 256)[base[q] + pp] = (unsigned short)(64 * j + lane);
                    base[q] += __builtin_popcountll(m);
                } }
        }
    }
    asm volatile("s_waitcnt lgkmcnt(0)" ::: "memory");
    int lane4 = lane; asm volatile("" : "+v"(lane4));
    const int nn = lane4 & 15, g = lane4 >> 4;
    LAS unsigned char* gb = lds + L_GATH + w * 8192;
#pragma unroll 1
    for (int q = 0; q < 4; ++q) {
        const int ql = 4 * w + q; if (ql >= nq) break;
        const int row = row0 + ql, pq = p0 + ql, nsel = pq + 1 < NSEL ? pq + 1 : NSEL, nch = (nsel + 31) >> 5;
        const LAS unsigned short* li = (const LAS unsigned short*)(lds + L_LIST) + (w * 4 + q) * 256;
        bf16x8 Bq[4];
#pragma unroll
        for (int ks = 0; ks < 4; ++ks) { if (nn < 8) Bq[ks] = *(const bf16x8*)(a.qlat + (size_t)row * 1024 + nn * 128 + ks * 32 + g * 8); else Bq[ks] = (bf16x8){0, 0, 0, 0, 0, 0, 0, 0}; }
        f32x4 o[8];
#pragma unroll
        for (int ct = 0; ct < 8; ++ct) o[ct] = (f32x4){0.f, 0.f, 0.f, 0.f};
        float mrun = -INFINITY, lrun = 0.f;
        const int gk = lane4 >> 1, gh = lane4 & 1;
        u32x4 pre[8];
        { const int slot = gk < nsel ? gk : 0; const size_t src = (kvb + li[slot]) * 128 + gh * 64;
#pragma unroll
          for (int jj = 0; jj < 8; ++jj) pre[jj] = *(const u32x4*)(a.ckv + src + jj * 8); }
#pragma unroll 1
        for (int c = 0; c < nch; ++c) {
#pragma unroll
            for (int jj = 0; jj < 8; ++jj) *(LAS u32x4*)(gb + off_b(gk, gh * 8 + jj)) = pre[jj];
            if (c + 1 < nch) { const int s_ = (c + 1) * 32 + gk; const int slot = s_ < nsel ? s_ : 0; const size_t src = (kvb + li[slot]) * 128 + gh * 64;
#pragma unroll
              for (int jj = 0; jj < 8; ++jj) pre[jj] = *(const u32x4*)(a.ckv + src + jj * 8); }
            asm volatile("" ::: "memory");
            bf16x8 Ak[2][4];
#pragma unroll
            for (int t2 = 0; t2 < 2; ++t2) { const unsigned krow = 8 * (nn >> 2) + (nn & 3) + 4 * t2;
#pragma unroll
                for (int ks = 0; ks < 4; ++ks) Ak[t2][ks] = *(const LAS bf16x8*)(gb + off_b(krow, 4 * ks + g)); }
            v4i16_t vlo[8], vhi[8];
            { const unsigned qq = (lane4 & 15) >> 2, pp = lane4 & 3;
#pragma unroll
              for (int ct = 0; ct < 8; ++ct) { vlo[ct] = __builtin_amdgcn_ds_read_tr16_b64_v4i16((LAS v4i16_t*)(gb + off_b(8 * g + qq, 2 * ct + (pp >> 1)) + 8 * (pp & 1)));
                  vhi[ct] = __builtin_amdgcn_ds_read_tr16_b64_v4i16((LAS v4i16_t*)(gb + off_b(8 * g + 4 + qq, 2 * ct + (pp >> 1)) + 8 * (pp & 1))); } }
            __builtin_amdgcn_sched_barrier(0);
            f32x4 s[2];
#pragma unroll
            for (int t2 = 0; t2 < 2; ++t2) s[t2] = (f32x4){0.f, 0.f, 0.f, 0.f};
#pragma unroll
            for (int ks = 0; ks < 4; ++ks)
#pragma unroll
                for (int t2 = 0; t2 < 2; ++t2) s[t2] = __builtin_amdgcn_mfma_f32_16x16x32_bf16(Ak[t2][ks], Bq[ks], s[t2], 0, 0, 0);
            float mx = -INFINITY;
#pragma unroll
            for (int t2 = 0; t2 < 2; ++t2)
#pragma unroll
                for (int r = 0; r < 4; ++r) { const int slot = c * 32 + 8 * g + r + 4 * t2; if (slot >= nsel) s[t2][r] = -INFINITY; mx = fmaxf(mx, s[t2][r]); }
            mx = fmaxf(mx, __shfl_xor(mx, 16)); mx = fmaxf(mx, __shfl_xor(mx, 32));
            const bool bump = __ballot(mx > mrun + 16.f) != 0ull;
            float alpha = 1.f;
            if (bump) { const float mnew = fmaxf(mrun, mx); alpha = __expf(mrun - mnew); mrun = mnew; lrun *= alpha;
#pragma unroll
                for (int ct = 0; ct < 8; ++ct) o[ct] = o[ct] * alpha; }
            float ps = 0.f; f32x4 p0v, p1v;
#pragma unroll
            for (int r = 0; r < 4; ++r) { p0v[r] = __expf(s[0][r] - mrun); p1v[r] = __expf(s[1][r] - mrun); ps += p0v[r] + p1v[r]; }
            lrun += ps;
            const u32x4 pw = pk8(p0v, p1v); const bf16x8 Pb = __builtin_bit_cast(bf16x8, pw);
#pragma unroll
            for (int ct = 0; ct < 8; ++ct) {
                const bf16x8 Akt = (bf16x8){vlo[ct][0], vlo[ct][1], vlo[ct][2], vlo[ct][3], vhi[ct][0], vhi[ct][1], vhi[ct][2], vhi[ct][3]};
                o[ct] = __builtin_amdgcn_mfma_f32_16x16x32_bf16(Akt, Pb, o[ct], 0, 0, 0);
            }
            asm volatile("" ::: "memory");
        }
        lrun += __shfl_xor(lrun, 16); lrun += __shfl_xor(lrun, 32);
        const float il = 1.f / lrun;
        if (nn < 8) {
#pragma unroll
            for (int ct = 0; ct < 8; ++ct) { u32x2 wv; wv.x = pk2(o[ct][0] * il, o[ct][1] * il); wv.y = pk2(o[ct][2] * il, o[ct][3] * il);
                *(LAS u32x2*)(lds + L_OLDS + ql * OL_PITCH + nn * 256 + (16 * ct + 4 * g) * 2) = wv; }
        }
    }
    __syncthreads();
    {
        int lane5 = lane; asm volatile("" : "+v"(lane5));
        const int r32 = lane5 & 31, hi = lane5 >> 5;
        f32x16 oa[2];
#pragma unroll
        for (int nt = 0; nt < 2; ++nt)
#pragma unroll
            for (int i = 0; i < 16; ++i) oa[nt][i] = 0.f;
        const bf16_t* wv = a.WuvT + (size_t)w * 64 * 128;
#pragma unroll
        for (int ks = 0; ks < 8; ++ks) {
            const bf16x8 Af = *(const LAS bf16x8*)(lds + L_OLDS + r32 * OL_PITCH + w * 256 + (ks * 16 + hi * 8) * 2);
#pragma unroll
            for (int nt = 0; nt < 2; ++nt) { const bf16x8 Bf = *(const bf16x8*)(wv + (size_t)(nt * 32 + r32) * 128 + ks * 16 + hi * 8); oa[nt] = __builtin_amdgcn_mfma_f32_32x32x16_bf16(Af, Bf, oa[nt], 0, 0, 0); }
        }
#pragma unroll
        for (int nt = 0; nt < 2; ++nt)
#pragma unroll
            for (int i = 0; i < 16; ++i) { const int ql = (i & 3) + 8 * (i >> 2) + 4 * hi; if (ql < nq) a.mix[(size_t)(row0 + ql) * 1024 + w * 64 + nt * 32 + r32] = f2bf(oa[nt][i]); }
    }
    __syncthreads();
}
__device__ __forceinline__ void phase(LAS unsigned char* lds, const Args& a) {
#pragma unroll 1
    for (int c = fresh_bid(); c < 256; c += gridDim.x) {
        const int bb = c >> 5, qt = c & 31, nu = c == 0 ? 3 : 2;
#pragma unroll 1
        for (int i = 0; i < nu; ++i) {
            const int qq = i == 0 ? 63 - qt : qt;
            const int b_ = i < 2 ? bb : 0, row0_ = i < 2 ? bb * SEQ + 32 * qq : MR, p0_ = i < 2 ? NMETA + 32 * qq : 0, nq_ = i < 2 ? 32 : NMETA;
            unit(lds, a, b_, row0_, p0_, nq_);
        }
    }
}
}
namespace ret {
constexpr int NCHK = 17, RP = 144;
constexpr int L_V = 0, L_K = 32768, L_S = L_K + 128 * 256, L_PART = L_S + 128 * RP, L_END = L_PART + 2048;
typedef short v4i16_t __attribute__((ext_vector_type(4)));
__device__ __forceinline__ unsigned off_b(unsigned row, unsigned ch) { return 256u * row + 16u * (ch ^ (((row & 3) << 2) | ((row >> 2) & 3))); }
__device__ __forceinline__ v4i16_t trr(LAS unsigned char* p) { return __builtin_amdgcn_ds_read_tr16_b64_v4i16((LAS v4i16_t*)p); }
struct Args { const bf16_t* qr; const bf16_t* kr; const bf16_t* vr; const bf16_t* sg; const float* rw; float* kvs; bf16_t* mix; };

template <bool KTR>
__device__ __forceinline__ void stage_kv(LAS unsigned char* lds, const Args& a, int b, int hh, int c, int tid) {
    const u32x4 z = (u32x4){0u, 0u, 0u, 0u};
#pragma unroll
    for (int j = 0; j < 4; ++j) { const int id = tid + 512 * j, row = id >> 4, ch = id & 15; const int p = c == 0 ? row - 112 : NMETA + 128 * (c - 1) + row;
        *(LAS u32x4*)(lds + L_V + off_b(row, ch)) = p >= 0 ? *(const u32x4*)(a.vr + ((size_t)b * T + p) * 512 + hh * 128 + ch * 8) : z; }
#pragma unroll
    for (int j = 0; j < 2; ++j) { const int id = tid + 512 * j, row = id >> 3, ch = id & 7; const int p = c == 0 ? row - 112 : NMETA + 128 * (c - 1) + row;
        const u32x4 v = p >= 0 ? *(const u32x4*)(a.kr + ((size_t)b * T + p) * 256 + hh * 64 + ch * 8) : z;
        if (KTR) *(LAS u32x4*)(lds + L_K + off_b(row, ch)) = v; else *(LAS u32x4*)(lds + L_K + row * RP + ch * 16) = v; }
}
__device__ __forceinline__ void r1_unit(LAS unsigned char* lds, const Args& a, int b, int hh, int c) {
    int tid = threadIdx.x; asm volatile("" : "+v"(tid));
    const int lane = tid & 63, w = __builtin_amdgcn_readfirstlane(tid >> 6), vt = w >> 1, dt = w & 1;
    __syncthreads();
    stage_kv<true>(lds, a, b, hh, c, tid);
    __syncthreads();
    const unsigned h = lane >> 5, blk = (lane >> 4) & 1, q = (lane & 15) >> 2, p = lane & 3;
    f32x16 acc;
#pragma unroll
    for (int i = 0; i < 16; ++i) acc[i] = 0.f;
#pragma unroll
    for (int ks = 0; ks < 8; ++ks) {
        const unsigned r0 = 16 * ks + 8 * h + q;
        const v4i16_t a0 = trr(lds + L_V + off_b(r0, 4 * vt + 2 * blk + (p >> 1)) + 8 * (p & 1)), a1 = trr(lds + L_V + off_b(r0 + 4, 4 * vt + 2 * blk + (p >> 1)) + 8 * (p & 1));
        const v4i16_t b0 = trr(lds + L_K + off_b(r0, 4 * dt + 2 * blk + (p >> 1)) + 8 * (p & 1)), b1 = trr(lds + L_K + off_b(r0 + 4, 4 * dt + 2 * blk + (p >> 1)) + 8 * (p & 1));
        const bf16x8 Af = (bf16x8){a0[0], a0[1], a0[2], a0[3], a1[0], a1[1], a1[2], a1[3]}, Bf = (bf16x8){b0[0], b0[1], b0[2], b0[3], b1[0], b1[1], b1[2], b1[3]};
        acc = __builtin_amdgcn_mfma_f32_32x32x16_bf16(Af, Bf, acc, 0, 0, 0);
    }
    const float g127 = exp2f(127.f * ret_log2_gamma(hh));
    float* dst = a.kvs + (((size_t)(b * 4 + hh) * NCHK + c) * 128) * 64;
#pragma unroll
    for (int i = 0; i < 16; ++i) { const int v = 32 * vt + (i & 3) + 8 * (i >> 2) + 4 * (int)h; dst[(size_t)v * 64 + 32 * dt + (lane & 31)] = acc[i] * g127; }
}
__device__ __forceinline__ void r2_unit(LAS unsigned char* lds, const Args& a, int b, int hh, int c) {
    int tid = threadIdx.x; asm volatile("" : "+v"(tid));
    const int lane = tid & 63, w = __builtin_amdgcn_readfirstlane(tid >> 6), qt = w & 3, vh = w >> 2, r32 = lane & 31, hi = lane >> 5;
    const float lg = ret_log2_gamma(hh);
    __syncthreads();
    stage_kv<false>(lds, a, b, hh, c, tid);
    { f32x4 s[4];
#pragma unroll
      for (int j = 0; j < 4; ++j) s[j] = (f32x4){0.f, 0.f, 0.f, 0.f};
      const float* src = a.kvs + ((size_t)(b * 4 + hh) * NCHK) * 8192 + tid * 4;
      for (int jc = 0; jc < c; ++jc) { const float wg = exp2f(lg * (float)(1 + 128 * (c - 1 - jc)));
#pragma unroll
          for (int j = 0; j < 4; ++j) s[j] += *(const f32x4*)(src + (size_t)jc * 8192 + j * 2048) * wg; }
#pragma unroll
      for (int j = 0; j < 4; ++j) { const int e = tid * 4 + j * 2048, v = e >> 6, d = e & 63; u32x2 wv; wv.x = pk2(s[j][0], s[j][1]); wv.y = pk2(s[j][2], s[j][3]); *(LAS u32x2*)(lds + L_S + v * RP + d * 2) = wv; } }
    const int nl_q = 32 * qt + r32; const int pq = c == 0 ? nl_q - 112 : NMETA + 128 * (c - 1) + nl_q;
    const bool qvalid = pq >= 0; const int qrow = c == 0 ? MR + (qvalid ? pq : 0) : b * SEQ + 128 * (c - 1) + nl_q;
    bf16x8 Bq[4];
#pragma unroll
    for (int ks = 0; ks < 4; ++ks) Bq[ks] = *(const bf16x8*)(a.qr + (size_t)qrow * 256 + hh * 64 + ks * 16 + hi * 8);
    __syncthreads();
    f32x16 oacc[2];
#pragma unroll
    for (int t = 0; t < 2; ++t) {
#pragma unroll
        for (int i = 0; i < 16; ++i) oacc[t][i] = 0.f;
#pragma unroll
        for (int ks = 0; ks < 4; ++ks) { const bf16x8 As = *(const LAS bf16x8*)(lds + L_S + (64 * vh + 32 * t + r32) * RP + ks * 32 + hi * 16); oacc[t] = __builtin_amdgcn_mfma_f32_32x32x16_bf16(As, Bq[ks], oacc[t], 0, 0, 0); }
    }
    const unsigned blk = (lane >> 4) & 1, q4 = (lane & 15) >> 2, p4 = lane & 3;
#pragma unroll 1
    for (int kt = 0; kt <= qt; ++kt) {
        f32x16 st;
#pragma unroll
        for (int i = 0; i < 16; ++i) st[i] = 0.f;
#pragma unroll
        for (int ks = 0; ks < 4; ++ks) { const bf16x8 Ak = *(const LAS bf16x8*)(lds + L_K + (32 * kt + r32) * RP + ks * 32 + hi * 16); st = __builtin_amdgcn_mfma_f32_32x32x16_bf16(Ak, Bq[ks], st, 0, 0, 0); }
        if (kt == qt) {
#pragma unroll
            for (int i = 0; i < 16; ++i) { const int kl = (i & 3) + 8 * (i >> 2) + 4 * hi; if (kl > r32) st[i] = 0.f; }
        }
#pragma unroll
        for (int s = 0; s < 2; ++s) {
            u32x4 pw; pw.x = pk2(st[8 * s], st[8 * s + 1]); pw.y = pk2(st[8 * s + 2], st[8 * s + 3]); pw.z = pk2(st[8 * s + 4], st[8 * s + 5]); pw.w = pk2(st[8 * s + 6], st[8 * s + 7]);
            const bf16x8 Bp = __builtin_bit_cast(bf16x8, pw);
#pragma unroll
            for (int t = 0; t < 2; ++t) {
                const unsigned r0 = 32 * kt + 16 * s + 4 * hi + q4, cch = 4 * (2 * vh + t) + 2 * blk + (p4 >> 1);
                const v4i16_t a0 = trr(lds + L_V + off_b(r0, cch) + 8 * (p4 & 1)), a1 = trr(lds + L_V + off_b(r0 + 8, cch) + 8 * (p4 & 1));
                const bf16x8 Av = (bf16x8){a0[0], a0[1], a0[2], a0[3], a1[0], a1[1], a1[2], a1[3]};
                oacc[t] = __builtin_amdgcn_mfma_f32_32x32x16_bf16(Av, Bp, oacc[t], 0, 0, 0);
            }
        }
    }
    float sm = 0.f, sq = 0.f;
#pragma unroll
    for (int t = 0; t < 2; ++t)
#pragma unroll
        for (int i = 0; i < 16; ++i) { sm += oacc[t][i]; sq += oacc[t][i] * oacc[t][i]; }
    sm += __shfl_xor(sm, 32); sq += __shfl_xor(sq, 32);
    LAS float* part = (LAS float*)(lds + L_PART);
    if (hi == 0) { part[(vh * 128 + nl_q) * 2] = sm; part[(vh * 128 + nl_q) * 2 + 1] = sq; }
    __syncthreads();
    const float tsm = part[nl_q * 2] + part[(128 + nl_q) * 2], tsq = part[nl_q * 2 + 1] + part[(128 + nl_q) * 2 + 1];
    const float mu = tsm * (1.f / 128.f), var = fmaxf(tsq * (1.f / 128.f) - mu * mu, 0.f), rstd = rsqrtf(var + EPS);
    if (qvalid && (c > 0 || b == 0)) {
#pragma unroll
        for (int t = 0; t < 2; ++t)
#pragma unroll
            for (int i4 = 0; i4 < 4; ++i4) {
                const int v = 64 * vh + 32 * t + 8 * i4 + 4 * hi;
                const f32x4 wv = *(const f32x4*)(a.rw + hh * 128 + v);
                const u32x2 gv = *(const u32x2*)(a.sg + (size_t)qrow * 512 + hh * 128 + v);
                const float g0 = bf2f((bf16_t)(gv.x & 0xffff)), g1 = bf2f((bf16_t)(gv.x >> 16)), g2 = bf2f((bf16_t)(gv.y & 0xffff)), g3 = bf2f((bf16_t)(gv.y >> 16));
                u32x2 ov; ov.x = pk2(g0 * ((oacc[t][4 * i4] - mu) * rstd * wv[0]), g1 * ((oacc[t][4 * i4 + 1] - mu) * rstd * wv[1]));
                ov.y = pk2(g2 * ((oacc[t][4 * i4 + 2] - mu) * rstd * wv[2]), g3 * ((oacc[t][4 * i4 + 3] - mu) * rstd * wv[3]));
                *(u32x2*)(a.mix + (size_t)qrow * 1024 + 512 + hh * 128 + v) = ov;
            }
    }
}
__device__ __forceinline__ void phase_r1(LAS unsigned char* lds, const Args& a) {
#pragma unroll 1
    for (int u = fresh_bid(); u < BATCH * 4 * 16; u += gridDim.x) r1_unit(lds, a, u >> 6, (u >> 4) & 3, u & 15);
    __syncthreads();
}
__device__ __forceinline__ void phase_r2(LAS unsigned char* lds, const Args& a) {
#pragma unroll 1
    for (int u = fresh_bid(); u < BATCH * 4 * 16 + 4; u += gridDim.x) { const bool m = u >= BATCH * 4 * 16; r2_unit(lds, a, m ? 0 : u >> 6, m ? u - BATCH * 4 * 16 : (u >> 4) & 3, m ? 0 : (u & 15) + 1); }
    __syncthreads();
}
}
constexpr size_t al256(size_t x) { return (x + 255) & ~(size_t)255; }
constexpr int LDS_BYTES = 160768;
struct WsMap { size_t bar, ctl, rot, WinT, WoT, WukT, WuvT, WrHi, WrLo, W1T, W2T, hb, U, qa, qi, wi, qr, sg, ckvr, ckv, ki, kr, vr, qlat, mix, kvs, hb1, hdn, list_tok, tok_e, tok_pos, tok_gate, end; };
constexpr WsMap make_map() {
    WsMap m{}; size_t o = 0;
    m.bar = o; o += al256(65536); m.ctl = o; o += al256(1 << 20); m.rot = o; o += al256((size_t)T * 32 * 8);
    m.WinT = o; o += al256((size_t)NL * DINP * D * 2); m.WoT = o; o += al256((size_t)NL * D * D * 2);
    m.WukT = o; o += al256((size_t)NL * 8 * 128 * 64 * 2); m.WuvT = o; o += al256((size_t)NL * 8 * 64 * 128 * 2);
    m.WrHi = o; o += al256((size_t)NL * 64 * D * 2); m.WrLo = o; o += al256((size_t)NL * 64 * D * 2);
    m.W1T = o; o += al256((size_t)NL * 65 * 512 * D * 2); m.W2T = o; o += al256((size_t)NL * 65 * D * 256 * 2);
    m.hb = o; o += al256((size_t)MP * D * 2);
    m.U = o; o += al256((size_t)RMAX * D * 2);
    const size_t oA = o;
    m.qa = o; o += al256((size_t)MP * 512 * 2); m.qi = o; o += al256((size_t)MP * 512 * 2); m.wi = o; o += al256((size_t)MP * 8 * 4);
    m.qr = o; o += al256((size_t)MP * 256 * 2); m.sg = o; o += al256((size_t)MP * 512 * 2);
    m.ckvr = o; o += al256((size_t)KVR * 128 * 2); m.ckv = o; o += al256((size_t)KVR * 128 * 2); m.ki = o; o += al256((size_t)(KVR + 512) * 64 * 2);
    m.kr = o; o += al256((size_t)KVR * 256 * 2); m.vr = o; o += al256((size_t)KVR * 512 * 2);
    m.qlat = o; o += al256((size_t)MP * 1024 * 2); m.mix = o; o += al256((size_t)MP * 1024 * 2); m.kvs = o; o += al256((size_t)BATCH * 4 * 17 * 8192 * 4);
    const size_t endA = o; o = oA;
    m.hb1 = o; o += al256((size_t)MP * D * 2); m.hdn = o; o += al256((size_t)RMAX * DE * 2);
    m.list_tok = o; o += al256((size_t)NE * LSTRIDE * 4);
    m.tok_e = o; o += al256((size_t)MP * 8 * 4); m.tok_pos = o; o += al256((size_t)MP * 8 * 4); m.tok_gate = o; o += al256((size_t)MP * 8 * 4);
    m.end = endA > o ? endA : o;
    return m;
}
constexpr WsMap WS = make_map();
struct MegaArgs { const float* in[20]; float* out; char* ws; };
#ifndef REP_MASK
#define REP_MASK 0
#endif
#define REPS(k) (((REP_MASK >> (k)) & 1) ? 2 : 1)
#ifndef USE_CG_SYNC
#define USE_CG_SYNC 1
#endif
#define GRID_SYNC() do { xcd_barrier(xbar); } while (0)
constexpr int L_XB = 160512;
constexpr size_t BAR_BYTES = 16384;
__global__ void __launch_bounds__(512, 2) mega(MegaArgs A) {
    extern __shared__ __attribute__((aligned(16))) unsigned char dynlds[];
    LAS unsigned char* lds = (LAS unsigned char*)dynlds;
    cg::grid_group grid = cg::this_grid();
    char* ws = A.ws;
    if (threadIdx.x < 2) ((LAS unsigned*)(lds + L_XB))[threadIdx.x] = 0u;
    __syncthreads();
    const XcdBarrier xbar = xcd_barrier_post((unsigned*)(ws + WS.bar), (volatile LAS unsigned*)(lds + L_XB));
#define WSP(T, f) ((T*)(ws + WS.f))
#define FRESH() do { size_t z_ = 0; asm volatile("" : "+s"(z_)); ws = A.ws + z_; asm volatile("" : "+s"(l)); } while (0)
    { ProArgs a; a.x = A.in[0]; a.meta = A.in[1]; a.w_in = A.in[2]; a.w_uk = A.in[3]; a.w_uv = A.in[4]; a.w_o = A.in[7]; a.w_router = A.in[10]; a.w_gate = A.in[12]; a.w_up = A.in[13]; a.w_down = A.in[14];
      a.ws_gate = A.in[15]; a.ws_up = A.in[16]; a.ws_down = A.in[17]; a.hb = WSP(bf16_t, hb); a.rot = WSP(f32x2, rot); a.WinT = WSP(bf16_t, WinT); a.WoT = WSP(bf16_t, WoT); a.WukT = WSP(bf16_t, WukT); a.WuvT = WSP(bf16_t, WuvT);
      a.WrHi = WSP(bf16_t, WrHi); a.WrLo = WSP(bf16_t, WrLo); a.W1T = WSP(bf16_t, W1T); a.W2T = WSP(bf16_t, W2T); a.ctl = WSP(int, ctl);
      for (int rep = 0; rep < REPS(0); ++rep) { if (rep) GRID_SYNC(); phase_prologue(lds, a); } }
    grid.sync();
#pragma unroll 1
    for (int l = 0; l < NL; ++l) {
        FRESH();
        { InProjArgs a; a.hb = WSP(bf16_t, hb); a.WinT = WSP(bf16_t, WinT) + (size_t)l * DINP * D; a.qa = WSP(bf16_t, qa); a.qi = WSP(bf16_t, qi); a.qr = WSP(bf16_t, qr); a.kr = WSP(bf16_t, kr); a.vr = WSP(bf16_t, vr); a.sg = WSP(bf16_t, sg);
          a.ckvr = WSP(bf16_t, ckvr); a.ki = WSP(bf16_t, ki); a.wi = WSP(float, wi); a.rot = WSP(f32x2, rot);
          for (int rep = 0; rep < REPS(1); ++rep) { if (rep) GRID_SYNC(); phase_inproj(lds, a); } }
        GRID_SYNC(); FRESH();
        { Pre2Args a; a.ckvr = WSP(bf16_t, ckvr); a.kvw = A.in[5] + (size_t)l * 128; a.ckv = WSP(bf16_t, ckv); a.qa = WSP(bf16_t, qa); a.WukT = WSP(bf16_t, WukT) + (size_t)l * 8 * 128 * 64; a.qlat = WSP(bf16_t, qlat);
          for (int rep = 0; rep < REPS(10); ++rep) { if (rep) GRID_SYNC(); phase_pre2(a); } }
        ret::Args ra; ra.qr = WSP(bf16_t, qr); ra.kr = WSP(bf16_t, kr); ra.vr = WSP(bf16_t, vr); ra.sg = WSP(bf16_t, sg); ra.rw = A.in[6] + (size_t)l * 512; ra.kvs = WSP(float, kvs); ra.mix = WSP(bf16_t, mix);
        for (int rep = 0; rep < REPS(2); ++rep) { if (rep) GRID_SYNC(); ret::phase_r1(lds, ra); }
        GRID_SYNC(); FRESH();
        ra.qr = WSP(bf16_t, qr); ra.kr = WSP(bf16_t, kr); ra.vr = WSP(bf16_t, vr); ra.sg = WSP(bf16_t, sg); ra.rw = A.in[6] + (size_t)l * 512; ra.kvs = WSP(float, kvs); ra.mix = WSP(bf16_t, mix);
        for (int rep = 0; rep < REPS(3); ++rep) { if (rep) GRID_SYNC(); ret::phase_r2(lds, ra); }
        { attn::Args a; a.qi = WSP(bf16_t, qi); a.wi = WSP(float, wi); a.ki = WSP(bf16_t, ki); a.qlat = WSP(bf16_t, qlat); a.ckv = WSP(bf16_t, ckv); a.WuvT = WSP(bf16_t, WuvT) + (size_t)l * 8 * 64 * 128; a.mix = WSP(bf16_t, mix);
          for (int rep = 0; rep < REPS(9); ++rep) { if (rep) GRID_SYNC(); attn::phase(lds, a); } }
        GRID_SYNC(); FRESH();
        { OutProjArgs a; a.mix = WSP(bf16_t, mix); a.WoT = WSP(bf16_t, WoT) + (size_t)l * D * D; a.h = WSP(bf16_t, hb); a.y = WSP(float, U);
          for (int rep = 0; rep < REPS(4); ++rep) { if (rep) GRID_SYNC(); phase_outproj(lds, a, MP / 256); } }
        GRID_SYNC(); FRESH();
        { int* cnt = WSP(int, ctl) + l * 64; route::Args a; a.y1 = WSP(float, U); a.g = A.in[8] + (size_t)l * D; a.bta = A.in[9] + (size_t)l * D; a.WrHi = WSP(bf16_t, WrHi) + (size_t)l * 64 * D; a.WrLo = WSP(bf16_t, WrLo) + (size_t)l * 64 * D; a.rbias = A.in[11] + (size_t)l * NE;
          a.hb1 = WSP(bf16_t, hb1); a.cnt = cnt; a.list_tok = WSP(int, list_tok); a.tok_e = WSP(int, tok_e); a.tok_pos = WSP(int, tok_pos); a.tok_gate = WSP(float, tok_gate);
          route::phase(lds, a); }
        GRID_SYNC(); FRESH();
        MoeArgs ma; { int* cnt = WSP(int, ctl) + l * 64; ma.cnt = cnt; } ma.hb1 = WSP(bf16_t, hb1); ma.W1T = WSP(bf16_t, W1T) + (size_t)l * 65 * 512 * D; ma.W2T = WSP(bf16_t, W2T) + (size_t)l * 65 * D * DE; ma.hdn = WSP(bf16_t, hdn); ma.yrows = WSP(bf16_t, U); ma.list_tok = WSP(int, list_tok);
        for (int rep = 0; rep < REPS(6); ++rep) { if (rep) GRID_SYNC(); phase_moe1(lds, ma); }
        GRID_SYNC(); FRESH();
        ma.cnt = WSP(int, ctl) + l * 64; ma.hb1 = WSP(bf16_t, hb1); ma.W1T = WSP(bf16_t, W1T) + (size_t)l * 65 * 512 * D; ma.W2T = WSP(bf16_t, W2T) + (size_t)l * 65 * D * DE; ma.hdn = WSP(bf16_t, hdn); ma.yrows = WSP(bf16_t, U); ma.list_tok = WSP(int, list_tok);
        for (int rep = 0; rep < REPS(7); ++rep) { if (rep) GRID_SYNC(); phase_moe2(lds, ma); }
        GRID_SYNC(); FRESH();
        { int* cnt = WSP(int, ctl) + l * 64; CombArgs a; a.hb1 = WSP(bf16_t, hb1); a.yrows = WSP(bf16_t, U); a.cnt = cnt; a.tok_e = WSP(int, tok_e); a.tok_pos = WSP(int, tok_pos); a.tok_gate = WSP(float, tok_gate); a.g = A.in[18] + (size_t)l * D; a.bta = A.in[19] + (size_t)l * D;
          a.hb = WSP(bf16_t, hb); a.out = l == NL - 1 ? A.out : nullptr;
          for (int rep = 0; rep < REPS(8); ++rep) { if (rep) GRID_SYNC(); phase_combine(lds, a); } }
        GRID_SYNC();
    }
#undef WSP
}
extern "C" void kernel_launch(void* const* d_in, const int* in_sizes, int n_in, void* d_out, int out_size, void* d_ws, size_t ws_size, hipStream_t stream) {
    static int grid_blocks = 0;
    if (grid_blocks == 0) {
        if (WS.end > ws_size || n_in != 20) { fprintf(stderr, "kernel_launch: workspace too small (%zu > %zu) or bad n_in %d\n", (size_t)WS.end, ws_size, n_in); grid_blocks = -1; return; }
        if (hipFuncSetAttribute((const void*)mega, hipFuncAttributeMaxDynamicSharedMemorySize, LDS_BYTES) != hipSuccess) { fprintf(stderr, "hipFuncSetAttribute failed\n"); grid_blocks = -1; return; }
        int dev = 0, cus = 0, per_cu = 0;
        (void)hipGetDevice(&dev); (void)hipDeviceGetAttribute(&cus, hipDeviceAttributeMultiprocessorCount, dev);
        (void)hipOccupancyMaxActiveBlocksPerMultiprocessor(&per_cu, (const void*)mega, 512, LDS_BYTES);
        if (per_cu < 1 || cus < 1) { fprintf(stderr, "kernel_launch: occupancy query failed (%d CUs, %d per CU)\n", cus, per_cu); grid_blocks = -1; return; }
        grid_blocks = cus;
        if (grid_blocks != 256) fprintf(stderr, "kernel_launch: note: %d CUs (tuned for 256)\n", grid_blocks);
    }
    if (grid_blocks < 0) return;
    if (hipMemsetAsync((char*)d_ws + WS.bar, 0, 65536, stream) != hipSuccess) { fprintf(stderr, "kernel_launch: memset of the barrier words failed\n"); return; }
    MegaArgs a; memset(&a, 0, sizeof(a));
    for (int i = 0; i < 20; ++i) a.in[i] = (const float*)d_in[i];
    a.out = (float*)d_out; a.ws = (char*)d_ws;
    void* args[] = {&a};
    hipError_t e = hipLaunchCooperativeKernel((const void*)mega, dim3(grid_blocks), dim3(512), args, LDS_BYTES, stream);
    if (e != hipSuccess) fprintf(stderr, "cooperative launch failed: %s (grid %d)\n", hipGetErrorString(e), grid_blocks);
}
```
